# Optimizing an MI355X kernel written in HIP

```python
import jax, jax.numpy as jnp
from jax import lax
import numpy as np

D_MODEL = 2048
BATCH = 4
SEQ = 2048
DEPTH = 1

N_META = 16
D_MIX = D_MODEL
D_LRU = D_MIX // 2
D_CONF = D_MIX - D_LRU
LRU_HEADS = 16
LRU_HEAD_DIM = D_LRU // LRU_HEADS
CONF_GROUPS = 16
LRU_CONV_WIDTH = 4
CONF_KERNEL = 31
LRU_C = 8.0
EPS = 1e-6
IN_COLS = 2 * D_LRU + 3 * D_CONF

kernel_name = "hymba_style_rglru_conformer_hybrid"


def rms_norm(x, w):
    xf = x.astype(jnp.float32)
    var = jnp.mean(xf * xf, axis=-1, keepdims=True)
    return (xf * lax.rsqrt(var + EPS) * w.astype(jnp.float32)).astype(x.dtype)


def layer_norm(x, w, b):
    xf = x.astype(jnp.float32)
    mu = jnp.mean(xf, axis=-1, keepdims=True)
    var = jnp.mean(jnp.square(xf - mu), axis=-1, keepdims=True)
    y = (xf - mu) * lax.rsqrt(var + EPS) * w.astype(jnp.float32) + b.astype(jnp.float32)
    return y.astype(x.dtype)


def causal_depthwise_conv(x, w, b):
    k, c = w.shape
    y = lax.conv_general_dilated(
        x, w.reshape(k, 1, c).astype(x.dtype),
        window_strides=(1,), padding=[(k - 1, 0)],
        dimension_numbers=("NWC", "WIO", "NWC"),
        feature_group_count=c)
    return y + b.astype(x.dtype)


def rg_lru(x, w_a, b_a, w_x, b_x, lam):
    bsz, t, _ = x.shape
    xh = x.reshape(bsz, t, LRU_HEADS, LRU_HEAD_DIM)
    r = jax.nn.sigmoid(jnp.einsum("bthi,hij->bthj", xh, w_a).reshape(bsz, t, D_LRU) + b_a)
    i = jax.nn.sigmoid(jnp.einsum("bthi,hij->bthj", xh, w_x).reshape(bsz, t, D_LRU) + b_x)
    log_a = -LRU_C * r.astype(jnp.float32) * jax.nn.softplus(-lam.astype(jnp.float32))
    a = jnp.exp(log_a)
    mult = jnp.sqrt(-jnp.expm1(2.0 * log_a))
    u = mult * (i * x).astype(jnp.float32)

    def combine(left, right):
        a1, b1 = left
        a2, b2 = right
        return a1 * a2, a2 * b1 + b2

    _, h = lax.associative_scan(combine, (a, u), axis=1)
    return h.astype(x.dtype)


def conformer_conv(u, dw_w, dw_b, ln_w, ln_b, pw_w, pw_b):
    v = u[..., :D_CONF] * jax.nn.sigmoid(u[..., D_CONF:])
    v = causal_depthwise_conv(v, dw_w, dw_b)
    v = jax.nn.silu(layer_norm(v, ln_w, ln_b))
    return v @ pw_w + pw_b


def setup_inputs(seed: int = 0) -> dict:
    key = jax.random.key(seed)
    ks = jax.random.split(key, 24)
    f32 = jnp.float32
    n = lambda k, shape, s: jax.random.normal(k, shape, f32) * s
    x = n(ks[0], (BATCH, SEQ, D_MODEL), 1.0)
    meta_tokens = n(ks[1], (N_META, D_MODEL), 1.0)
    pre_norm_w = 1.0 + n(ks[2], (DEPTH, D_MODEL), 0.02)
    post_norm_w = 1.0 + n(ks[3], (DEPTH, D_MODEL), 0.02)
    w_in = n(ks[4], (DEPTH, D_MODEL, IN_COLS), D_MODEL ** -0.5)
    b_in = n(ks[5], (DEPTH, IN_COLS), 0.01)
    lru_conv_w = n(ks[6], (DEPTH, LRU_CONV_WIDTH, D_LRU), LRU_CONV_WIDTH ** -0.5)
    lru_conv_b = n(ks[7], (DEPTH, D_LRU), 0.01)
    w_gate_a = n(ks[8], (DEPTH, LRU_HEADS, LRU_HEAD_DIM, LRU_HEAD_DIM), LRU_HEAD_DIM ** -0.5)
    b_gate_a = n(ks[9], (DEPTH, D_LRU), 0.01)
    w_gate_x = n(ks[10], (DEPTH, LRU_HEADS, LRU_HEAD_DIM, LRU_HEAD_DIM), LRU_HEAD_DIM ** -0.5)
    b_gate_x = n(ks[11], (DEPTH, D_LRU), 0.01)
    a_c = jax.random.uniform(ks[12], (DEPTH, D_LRU), f32, 0.9, 0.999)
    a0 = a_c ** (1.0 / LRU_C)
    lru_lambda = jnp.log(a0) - jnp.log1p(-a0)
    conf_dw_w = n(ks[13], (DEPTH, CONF_KERNEL, D_CONF), CONF_KERNEL ** -0.5)
    conf_dw_b = n(ks[14], (DEPTH, D_CONF), 0.01)
    conf_ln_w = 1.0 + n(ks[15], (DEPTH, D_CONF), 0.02)
    conf_ln_b = n(ks[16], (DEPTH, D_CONF), 0.01)
    conf_pw_w = n(ks[17], (DEPTH, D_CONF, D_CONF), D_CONF ** -0.5)
    conf_pw_b = n(ks[18], (DEPTH, D_CONF), 0.01)
    w_out = n(ks[19], (DEPTH, D_MIX, D_MODEL), D_MIX ** -0.5)
    return {
        "x": x, "meta_tokens": meta_tokens,
        "pre_norm_w": pre_norm_w, "post_norm_w": post_norm_w,
        "w_in": w_in, "b_in": b_in,
        "lru_conv_w": lru_conv_w, "lru_conv_b": lru_conv_b,
        "w_gate_a": w_gate_a, "b_gate_a": b_gate_a,
        "w_gate_x": w_gate_x, "b_gate_x": b_gate_x,
        "lru_lambda": lru_lambda,
        "conf_dw_w": conf_dw_w, "conf_dw_b": conf_dw_b,
        "conf_ln_w": conf_ln_w, "conf_ln_b": conf_ln_b,
        "conf_pw_w": conf_pw_w, "conf_pw_b": conf_pw_b,
        "w_out": w_out,
    }


def reference(x, meta_tokens, pre_norm_w, post_norm_w, w_in, b_in,
              lru_conv_w, lru_conv_b, w_gate_a, b_gate_a, w_gate_x, b_gate_x,
              lru_lambda, conf_dw_w, conf_dw_b, conf_ln_w, conf_ln_b,
              conf_pw_w, conf_pw_b, w_out):
    bsz = x.shape[0]
    meta = jnp.broadcast_to(meta_tokens.astype(x.dtype)[None], (bsz, N_META, D_MODEL))
    h = jnp.concatenate([meta, x], axis=1)
    for l in range(DEPTH):
        hn = rms_norm(h, pre_norm_w[l])
        z = hn @ w_in[l] + b_in[l]
        x_lru = z[..., :D_LRU]
        g_lru = z[..., D_LRU:2 * D_LRU]
        u_conf = z[..., 2 * D_LRU:2 * D_LRU + 2 * D_CONF]
        g_conf = z[..., 2 * D_LRU + 2 * D_CONF:]
        xc = causal_depthwise_conv(x_lru, lru_conv_w[l], lru_conv_b[l])
        y_lru = rg_lru(xc, w_gate_a[l], b_gate_a[l], w_gate_x[l], b_gate_x[l],
                       lru_lambda[l]) * jax.nn.silu(g_lru)
        y_conf = conformer_conv(u_conf, conf_dw_w[l], conf_dw_b[l], conf_ln_w[l],
                                conf_ln_b[l], conf_pw_w[l], conf_pw_b[l]) * jax.nn.silu(g_conf)
        y = jnp.concatenate([y_lru, y_conf], axis=-1) @ w_out[l]
        h = h + rms_norm(y, post_norm_w[l])
    return h[:, N_META:]
```

```cpp
#include <hip/hip_runtime.h>
#include <cstdio>
#include <cstdint>
#include <utility>

#define LAS __attribute__((address_space(3)))
typedef unsigned short bf16_t;
typedef short bf16x8 __attribute__((ext_vector_type(8)));
typedef float f32x4 __attribute__((ext_vector_type(4)));
typedef float f32x2 __attribute__((ext_vector_type(2)));
typedef unsigned u32x4 __attribute__((ext_vector_type(4)));
typedef unsigned u32x2 __attribute__((ext_vector_type(2)));

constexpr int DM = 2048, NBATCH = 4, SEQ = 2048, NMETA = 16, MX = NBATCH * SEQ  , MPAD = MX + 256  , NIN = 5120, DL = 1024, DC = 1024;
constexpr int ZC_XL = 0, ZC_GL = 1024, ZC_U1 = 2048, ZC_U2 = 3072, ZC_GC = 4096;
constexpr float EPS = 1e-6f;
constexpr size_t MiB = 1u << 20;
constexpr size_t WS_W1T = 1 * MiB;
constexpr size_t WS_W3T = 22 * MiB;
constexpr size_t WS_WPT = 30 * MiB;
constexpr size_t WS_HN = 32 * MiB;
constexpr size_t WS_Z = 66 * MiB;
constexpr size_t WS_VLN = 150 * MiB;
constexpr size_t WS_Y = 166 * MiB;
constexpr size_t WS_PART = 198 * MiB;
constexpr size_t WS_CARRY = 199 * MiB;
constexpr size_t WS_END = 200 * MiB;
static_assert(WS_W1T + (size_t)NIN * DM * 2 <= WS_W3T && WS_HN + (size_t)MPAD * DM * 2 <= WS_Z && WS_Z + (size_t)MPAD * NIN * 2 <= WS_VLN, "ws map");
constexpr int LDS_BYTES = 149504, L_MISC = 148480;
constexpr size_t WS_CTL = 0, CTL_BYTES = 32768;
constexpr unsigned INIT_TOKEN = 0x5EEDC0DEu;
constexpr int PROBE_SYNC = 0, PROBE_P0 = 0, PROBE_P1 = 0, PROBE_P2B = 0, PROBE_P3 = 0;

__device__ __forceinline__ unsigned cvt_pk_bf16(float lo, float hi) { unsigned r; asm volatile("v_cvt_pk_bf16_f32 %0, %1, %2" : "=v"(r) : "v"(lo), "v"(hi)); return r; }
__device__ __forceinline__ float bf_lo(unsigned w) { return __uint_as_float(w << 16); }
__device__ __forceinline__ float bf_hi(unsigned w) { return __uint_as_float(w & 0xffff0000u); }
__device__ __forceinline__ float sigm(float x) { return __builtin_amdgcn_rcpf(1.0f + __expf(-x)); }
__device__ __forceinline__ float siluf(float x) { return x * sigm(x); }


#define XB_TMO      128
#define XB_XCNT(j)  (256  + 64 * (j))
#define XB_XSUB(j)  (1280 + 64 * (j))
#define XB_XGEN(j)  (2304 + 64 * (j))
#define XB_TOP      3328
#define XB_TOPGEN   3392
#define XCD_BAR_WORDS 3456
#define XB_SPIN_CAP (1u << 18)
__device__ __forceinline__ unsigned xb_ld(unsigned* p)              { return __hip_atomic_load(p, __ATOMIC_RELAXED, __HIP_MEMORY_SCOPE_AGENT); }
__device__ __forceinline__ unsigned xb_add(unsigned* p, unsigned v) { return __hip_atomic_fetch_add(p, v, __ATOMIC_RELAXED, __HIP_MEMORY_SCOPE_AGENT); }
__device__ __forceinline__ unsigned xb_xcc_id() { return (unsigned)__builtin_amdgcn_s_getreg((3 << 11) | 20) & 0xFu; }
#define XB_SPIN(cond, bar) do { unsigned _sp = 0; while (cond) { __builtin_amdgcn_s_sleep(1); \
    if ((++_sp & 255u) == 0u) { if (xb_ld(&(bar)[XB_TMO])) break; if (_sp > XB_SPIN_CAP) { atomicAdd(&(bar)[XB_TMO], 1u); break; } } } } while (0)
struct XcdBarrier { unsigned* bar; unsigned x; volatile LAS unsigned* st; };
__device__ __forceinline__ XcdBarrier xcd_barrier_post(unsigned* bar, volatile LAS unsigned* st) {
    XcdBarrier b; b.bar = bar; b.x = xb_xcc_id(); b.st = st;
    if (threadIdx.x == 0) (void)xb_add(&bar[XB_XCNT(b.x)], 1u);
    return b;
}
__device__ __forceinline__ void xcd_barrier_complete(unsigned* bar, unsigned x, unsigned& nloc, unsigned& nx) {
    const unsigned G = gridDim.x * gridDim.y * gridDim.z;
    unsigned sum, cnt, mine, sp = 0u;
    for (;;) {
        sum = 0u; cnt = 0u; mine = 0u;
#pragma unroll
        for (unsigned j = 0; j < 16; ++j) { const unsigned c = xb_ld(&bar[XB_XCNT(j)]); sum += c; cnt += (c > 0u) ? 1u : 0u; mine = (j == x) ? c : mine; }
        if (sum == G) break;
        __builtin_amdgcn_s_sleep(1);
        if ((++sp & 255u) == 0u) { if (xb_ld(&bar[XB_TMO])) break; if (sp > XB_SPIN_CAP) { atomicAdd(&bar[XB_TMO], 1u); break; } }
    }
    nloc = mine > 0u ? mine : 1u; nx = cnt > 0u ? cnt : 1u;
}
__device__ __forceinline__ void xcd_barrier(const XcdBarrier& b) {
    asm volatile("s_waitcnt vmcnt(0)" ::: "memory");
    __syncthreads();
    if (threadIdx.x == 0) {
        unsigned* bar = b.bar;
        __builtin_amdgcn_s_waitcnt(0);
        unsigned nloc = b.st[0], nx = b.st[1];
        if (nloc == 0u) { xcd_barrier_complete(bar, b.x, nloc, nx); b.st[0] = nloc; b.st[1] = nx; }
        const unsigned old = xb_add(&bar[XB_XSUB(b.x)], 1u);
        const unsigned gen = old / nloc;
        if (old + 1u == (gen + 1u) * nloc) {
            __builtin_amdgcn_fence(__ATOMIC_RELEASE, "agent");
            asm volatile("s_waitcnt vmcnt(0)" ::: "memory");
            const unsigned og = xb_add(&bar[XB_TOP], 1u);
            const unsigned tg = og / nx;
            if (og + 1u == (tg + 1u) * nx) xb_add(&bar[XB_TOPGEN], 1u);
            else XB_SPIN(xb_ld(&bar[XB_TOPGEN]) == tg, bar);
            __builtin_amdgcn_fence(__ATOMIC_ACQUIRE, "agent");
            xb_add(&bar[XB_XGEN(b.x)], 1u);
            asm volatile("s_waitcnt vmcnt(0)" ::: "memory");
        } else {
            XB_SPIN(xb_ld(&bar[XB_XGEN(b.x)]) == gen, bar);
            __builtin_amdgcn_fence(__ATOMIC_ACQUIRE, "agent");
            asm volatile("s_waitcnt vmcnt(0)" ::: "memory");
        }
    }
    __syncthreads();
}

namespace pg8 {
#define PG8_LAS __attribute__((address_space(3)))
constexpr int BM = 256, BK = 64, HALF = 128, HTB = HALF * BK * 2, STAGE_BYTES = 8 * HTB, NXCD = 8, WGM = 8;
__host__ __device__ __forceinline__ int lds_byte(int r, int c) { const int st = (r >> 4) * 2 + (c >> 5), rr = r & 15, cc = c & 31, ob = rr * 64 + cc * 2; return st * 1024 + (ob ^ (((ob >> 9) & 1) << 5)); }
__host__ __device__ __forceinline__ void stage_rc(int b, int& R, int& C) { const int st = b / 1024, sb = b % 1024, swz = sb ^ (((sb >> 9) & 1) << 5); R = (st >> 1) * 16 + swz / 64; C = (st & 1) * 32 + (swz % 64) / 2; }
__host__ __device__ __forceinline__ int perm32(int rho) { const int n = rho >> 4, i = rho & 15; return 8 * (i >> 2) + 4 * n + (i & 3); }
struct Unit { int pm, pn; };
struct Gemm { const bf16_t* A; const bf16_t* Bt; int M, N, K; };
struct StaticOrder {
    int nM, nN, nwg, G, c, nlim;
    __host__ __device__ void init(int M, int N, int G_, int c_) { nM = M / BM; nN = N / BM; nwg = nM * nN; G = G_; c = c_; nlim = nwg; }
    __host__ __device__ bool at(long L, Unit& u) const {
        int wgid = (int)L; { const int q = nwg / NXCD, r = nwg % NXCD, xcd = wgid % NXCD, off = wgid / NXCD; wgid = (xcd < r ? xcd * (q + 1) : r * (q + 1) + (xcd - r) * q) + off; }
        const int nig = WGM * nN, gid = wgid / nig, fm = gid * WGM, gsz = (nM - fm) < WGM ? (nM - fm) : WGM;
        u.pm = fm + ((wgid % nig) % gsz); u.pn = (wgid % nig) / gsz; return true;
    }
    __host__ __device__ bool next(int i, Unit& u) const { const long L = (long)i * G + c; if (L >= nlim) return false; return at(L, u); }
    __device__ __forceinline__ void a_ready(const Unit&) const {}
    __device__ __forceinline__ void done(const Unit&) const {}
};
struct EpiZ {
    static constexpr bool PERM = true, AFTER_DRAIN = false;
    bf16_t* O; int ldc; const float* bias; int pn_off;
    template <int NAI> __device__ __forceinline__ void run(const f32x4 (&acc)[NAI][2][4][2], int rowbase, int pn_, int wr, int wc, int fr, int fq) const {
        const int row0 = rowbase + wr * 64 + fr; const int pn = pn_ + pn_off;
        const bool glu = (pn >= 8 && pn < 16);
        const int cin = wc * 32 + 8 * fq;
        const int bc0 = glu ? ZC_U1 + 128 * (pn - 8) + cin : pn * BM + cin;
        const int bc1 = glu ? ZC_U2 + 128 * (pn - 8) + cin : pn * BM + HALF + cin;
        f32x4 bv[2][2];
#pragma unroll
        for (int n = 0; n < 2; ++n) { bv[0][n] = *(const f32x4*)(bias + bc0 + 4 * n); bv[1][n] = *(const f32x4*)(bias + bc1 + 4 * n); }
        if (glu) {
#pragma unroll
            for (int ai = 0; ai < NAI; ++ai)
#pragma unroll
                for (int m = 0; m < 4; ++m) { bf16_t* rowp = O + (size_t)(row0 + ai * HALF + m * 16) * ldc + bc0;
                    const f32x4 a0 = acc[ai][0][m][0] + bv[0][0], a1 = acc[ai][0][m][1] + bv[0][1], g0 = acc[ai][1][m][0] + bv[1][0], g1 = acc[ai][1][m][1] + bv[1][1];
                    u32x4 w; w.x = cvt_pk_bf16(a0[0] * sigm(g0[0]), a0[1] * sigm(g0[1])); w.y = cvt_pk_bf16(a0[2] * sigm(g0[2]), a0[3] * sigm(g0[3]));
                    w.z = cvt_pk_bf16(a1[0] * sigm(g1[0]), a1[1] * sigm(g1[1])); w.w = cvt_pk_bf16(a1[2] * sigm(g1[2]), a1[3] * sigm(g1[3]));
                    *(u32x4*)rowp = w; }
        } else {
#pragma unroll
            for (int ai = 0; ai < NAI; ++ai)
#pragma unroll
                for (int m = 0; m < 4; ++m) { bf16_t* rowp = O + (size_t)(row0 + ai * HALF + m * 16) * ldc + bc0;
#pragma unroll
                    for (int bj = 0; bj < 2; ++bj) { const f32x4 v0 = acc[ai][bj][m][0] + bv[bj][0], v1 = acc[ai][bj][m][1] + bv[bj][1];
                        u32x4 w; w.x = cvt_pk_bf16(v0[0], v0[1]); w.y = cvt_pk_bf16(v0[2], v0[3]); w.z = cvt_pk_bf16(v1[0], v1[1]); w.w = cvt_pk_bf16(v1[2], v1[3]);
                        *(u32x4*)(rowp + bj * HALF) = w; } }
        }
    }
};
struct EpiPW {
    static constexpr bool PERM = true, AFTER_DRAIN = false;
    bf16_t* Y; const bf16_t* Z; const float* bias;
    template <int NAI> __device__ __forceinline__ void run(const f32x4 (&acc)[NAI][2][4][2], int rowbase, int pn, int wr, int wc, int fr, int fq) const {
        const int row0 = rowbase + wr * 64 + fr; const int col0 = pn * BM + wc * 32 + 8 * fq;
        f32x4 bv[2][2];
#pragma unroll
        for (int bj = 0; bj < 2; ++bj)
#pragma unroll
            for (int n = 0; n < 2; ++n) bv[bj][n] = *(const f32x4*)(bias + col0 + bj * HALF + 4 * n);
#pragma unroll
        for (int ai = 0; ai < NAI; ++ai)
#pragma unroll
            for (int m = 0; m < 4; ++m) { const size_t row = (size_t)(row0 + ai * HALF + m * 16);
#pragma unroll
                for (int bj = 0; bj < 2; ++bj) { const f32x4 v0 = acc[ai][bj][m][0] + bv[bj][0], v1 = acc[ai][bj][m][1] + bv[bj][1];
                    const u32x4 g = *(const u32x4*)(Z + row * NIN + ZC_GC + col0 + bj * HALF);
                    u32x4 w;
                    w.x = cvt_pk_bf16(v0[0] * siluf(bf_lo(g.x)), v0[1] * siluf(bf_hi(g.x)));
                    w.y = cvt_pk_bf16(v0[2] * siluf(bf_lo(g.y)), v0[3] * siluf(bf_hi(g.y)));
                    w.z = cvt_pk_bf16(v1[0] * siluf(bf_lo(g.z)), v1[1] * siluf(bf_hi(g.z)));
                    w.w = cvt_pk_bf16(v1[2] * siluf(bf_lo(g.w)), v1[3] * siluf(bf_hi(g.w)));
                    *(u32x4*)(Y + row * DM + DL + col0 + bj * HALF) = w; } }
    }
};
struct EpiOut {
    static constexpr bool PERM = false, AFTER_DRAIN = true;
    const float* x; float* out; const float* pw; float* part; unsigned* cnt;
    __device__ __forceinline__ void fused(f32x4 (&acc)[2][2][4][2], const Unit& u, int wr, int wc, int fr, int fq, PG8_LAS unsigned char* lds, int wid, int lane) const {
        PG8_LAS float* P = (PG8_LAS float*)lds;
        PG8_LAS float* S = (PG8_LAS float*)(lds + 8192);
#pragma unroll
        for (int ai = 0; ai < 2; ++ai)
#pragma unroll
            for (int m = 0; m < 4; ++m) { float s = 0.f;
#pragma unroll
                for (int bj = 0; bj < 2; ++bj)
#pragma unroll
                    for (int n = 0; n < 2; ++n) { const f32x4 v = acc[ai][bj][m][n]; s += (v[0] * v[0] + v[1] * v[1]) + (v[2] * v[2] + v[3] * v[3]); }
                s += __shfl_xor(s, 16); s += __shfl_xor(s, 32);
                if (fq == 0) P[(ai * HALF + wr * 64 + m * 16 + fr) * 4 + wc] = s; }
        __syncthreads();
        const int tid = wid * 64 + lane;
        if (tid < 256) { const float t = (P[tid * 4 + 0] + P[tid * 4 + 1]) + (P[tid * 4 + 2] + P[tid * 4 + 3]); __hip_atomic_store(part + (size_t)(u.pm * BM + tid) * 8 + u.pn, t, __ATOMIC_RELAXED, __HIP_MEMORY_SCOPE_AGENT);
            asm volatile("s_waitcnt vmcnt(0)" ::: "memory");
            if (lane == 0) __hip_atomic_fetch_add(cnt + 64 * u.pm, 1u, __ATOMIC_RELAXED, __HIP_MEMORY_SCOPE_AGENT); }
        PG8_LAS float* T = (PG8_LAS float*)(lds + 9216);
        constexpr int TS = 260;
        const size_t gbase = (size_t)(u.pm * BM) * DM + (size_t)u.pn * BM + 4 * lane;
        f32x4 xr[16];
        f32x4 xr2[16];
        if (wid != 0) {
#pragma unroll
            for (int rr = 0; rr < 16; ++rr) xr[rr] = __builtin_nontemporal_load((const f32x4*)(x + gbase + (size_t)(wid * 16 + rr) * DM));
        }
#pragma unroll
        for (int m = 0; m < 4; ++m)
#pragma unroll
            for (int bj = 0; bj < 2; ++bj)
#pragma unroll
                for (int n = 0; n < 2; ++n) *(PG8_LAS f32x4*)(T + (wr * 64 + m * 16 + fr) * TS + bj * HALF + wc * 32 + n * 16 + 4 * fq) = acc[0][bj][m][n];
        if (wid != 0) {
#pragma unroll
            for (int rr = 0; rr < 16; ++rr) xr2[rr] = __builtin_nontemporal_load((const f32x4*)(x + gbase + (size_t)(HALF + wid * 16 + rr) * DM));
        }
        if (wid == 0) {
            unsigned sp = 0;
            while ((unsigned)__builtin_amdgcn_readfirstlane(__hip_atomic_load(cnt + 64 * u.pm, __ATOMIC_RELAXED, __HIP_MEMORY_SCOPE_AGENT)) < 32u) { __builtin_amdgcn_s_sleep(2); if (++sp > (1u << 22)) break; }
            __builtin_amdgcn_fence(__ATOMIC_ACQUIRE, "agent");
            asm volatile("s_waitcnt vmcnt(0)" ::: "memory");
#pragma unroll
            for (int rr = 0; rr < 16; ++rr) { xr[rr] = __builtin_nontemporal_load((const f32x4*)(x + gbase + (size_t)(rr) * DM)); xr2[rr] = __builtin_nontemporal_load((const f32x4*)(x + gbase + (size_t)(HALF + rr) * DM)); }
        }
        __syncthreads();
        if (tid < 256) { const float* pp = part + (size_t)(u.pm * BM + tid) * 8; float t = 0.f;
#pragma unroll
            for (int k = 0; k < 8; ++k) t += __hip_atomic_load(pp + k, __ATOMIC_RELAXED, __HIP_MEMORY_SCOPE_AGENT);
            S[tid] = 1.0f / sqrtf(t * (1.0f / (float)DM) + EPS); }
        const f32x4 wv = *(const f32x4*)(pw + u.pn * BM + 4 * lane);
#pragma unroll
        for (int ai = 0; ai < 2; ++ai) {
            if (ai == 1) {
                __syncthreads();
#pragma unroll
                for (int m = 0; m < 4; ++m)
#pragma unroll
                    for (int bj = 0; bj < 2; ++bj)
#pragma unroll
                        for (int n = 0; n < 2; ++n) *(PG8_LAS f32x4*)(T + (wr * 64 + m * 16 + fr) * TS + bj * HALF + wc * 32 + n * 16 + 4 * fq) = acc[1][bj][m][n];
            }
            __syncthreads();
#pragma unroll
            for (int rr = 0; rr < 16; ++rr) { const int rl = wid * 16 + rr; const float rs = S[ai * HALF + rl];
                const f32x4 y = *(const PG8_LAS f32x4*)(T + rl * TS + 4 * lane);
                const f32x4 o = (ai == 0 ? xr[rr] : xr2[rr]) + y * rs * wv;
                __builtin_nontemporal_store(o, (f32x4*)(out + gbase + (size_t)(ai * HALF + rl) * DM)); }
        }
    }
};

template <class Epi, class Sched, bool ALIGN_EPI = false>
__device__ __forceinline__ void gemm_phase(PG8_LAS unsigned char* lds, const Gemm g, const Sched& S, const Epi& E) {
    int tid = threadIdx.x; asm volatile("" : "+v"(tid));
    const int wid = __builtin_amdgcn_readfirstlane(tid >> 6), lane = tid & 63, wr = wid >> 2, wc = wid & 3, fr = lane & 15, fq = lane >> 4;
    const int K = g.K, nt = K / BK;
    unsigned voffA[2], voffB[2];
#pragma unroll
    for (int i = 0; i < 2; ++i) { int R, C; stage_rc(tid * 16 + i * 8192, R, C); const int Rb = Epi::PERM ? ((R & ~31) + perm32(R & 31)) : R;
        voffA[i] = (unsigned)(R * K + C) * 2u; voffB[i] = (unsigned)(Rb * K + C) * 2u; }
    const size_t kstep = (size_t)(BK * 2);
    const size_t hstep = (size_t)HALF * K * 2;
    const size_t tstep = 2 * hstep;
    const unsigned ldsw = (unsigned)wid * 1024u;
    const int aoff = lds_byte(wr * 64 + fr, fq * 8), boff = lds_byte(wc * 32 + fr, fq * 8);
#define PG8_SA(b, h) (((b) * 2 + (h)) * HTB)
#define PG8_SB(b, h) ((4 + (b) * 2 + (h)) * HTB)
#define PG8_STAGE(bufoff, gbase, voff) do { _Pragma("unroll") for (int _i = 0; _i < 2; ++_i) \
        __builtin_amdgcn_global_load_lds((const unsigned*)((const char*)(gbase) + (voff)[_i]), (PG8_LAS unsigned*)(lds + (bufoff) + ldsw + _i * 8192), 16, 0, 0); } while (0)
#define PG8_LDA(dst, b, h) do { _Pragma("unroll") for (int m = 0; m < 4; ++m) _Pragma("unroll") for (int k = 0; k < 2; ++k) dst[m][k] = *(const PG8_LAS bf16x8*)(lds + PG8_SA(b, h) + aoff + m * 2048 + k * 1024); } while (0)
#define PG8_LDB(dst, b, h) do { _Pragma("unroll") for (int n = 0; n < 2; ++n) _Pragma("unroll") for (int k = 0; k < 2; ++k) dst[n][k] = *(const PG8_LAS bf16x8*)(lds + PG8_SB(b, h) + boff + n * 2048 + k * 1024); } while (0)
#define PG8_MMA(ai, bj, At, Bt) do { __builtin_amdgcn_s_setprio(1); _Pragma("unroll") for (int m = 0; m < 4; ++m) _Pragma("unroll") for (int n = 0; n < 2; ++n) _Pragma("unroll") for (int k = 0; k < 2; ++k) \
        acc[ai][bj][m][n] = __builtin_amdgcn_mfma_f32_16x16x32_bf16(Bt[n][k], At[m][k], acc[ai][bj][m][n], 0, 0, 0); __builtin_amdgcn_s_setprio(0); } while (0)
#define PG8_WAIT_V(n) asm volatile("s_waitcnt vmcnt(" #n ")" ::: "memory")
#define PG8_WAIT_L(n) asm volatile("s_waitcnt lgkmcnt(" #n ")" ::: "memory")
#define PG8_BAR __builtin_amdgcn_s_barrier()
#define PG8_SCHED __builtin_amdgcn_sched_barrier(0)
    Unit cur, nxt; int ui = 0;
    if (!S.next(0, cur)) return;
    f32x4 acc[2][2][4][2];
#pragma unroll
    for (int a = 0; a < 2; ++a)
#pragma unroll
        for (int b = 0; b < 2; ++b)
#pragma unroll
            for (int m = 0; m < 4; ++m)
#pragma unroll
                for (int n = 0; n < 2; ++n) acc[a][b][m][n] = (f32x4){0.f, 0.f, 0.f, 0.f};
    bf16x8 At[4][2], B0[2][2], B1[2][2];
    const char* cA = (const char*)g.A + (size_t)cur.pm * tstep; const char* cB = (const char*)g.Bt + (size_t)cur.pn * tstep;
    S.a_ready(cur);
    PG8_STAGE(PG8_SB(0, 0), cB, voffB); PG8_STAGE(PG8_SB(0, 1), cB + hstep, voffB); PG8_STAGE(PG8_SA(0, 0), cA, voffA); PG8_STAGE(PG8_SA(0, 1), cA + hstep, voffA);
    if (wr == 1) PG8_BAR;
    PG8_WAIT_V(2); PG8_BAR;
    PG8_STAGE(PG8_SB(1, 0), cB + kstep, voffB); PG8_STAGE(PG8_SA(1, 0), cA + kstep, voffA); PG8_STAGE(PG8_SB(1, 1), cB + hstep + kstep, voffB);
    PG8_WAIT_V(6); PG8_BAR;
    for (;;) {
        const bool has_next = S.next(ui + 1, nxt);
        const char* nA = has_next ? (const char*)g.A + (size_t)nxt.pm * tstep : cA; const char* nB = has_next ? (const char*)g.Bt + (size_t)nxt.pn * tstep : cB;
        for (int t = 0; t < nt; t += 2) {
            const bool last = (t == nt - 2);
            const char* a1 = cA + (size_t)(t + 1) * kstep;
            const char* a2 = last ? nA : cA + (size_t)(t + 2) * kstep; const char* b2 = last ? nB : cB + (size_t)(t + 2) * kstep;
            const char* a3 = a2 + kstep; const char* b3 = b2 + kstep;
            if (last && has_next) S.a_ready(nxt);
            PG8_LDB(B0, 0, 0); PG8_LDB(B1, 0, 1); PG8_SCHED; PG8_LDA(At, 0, 0); PG8_STAGE(PG8_SA(1, 1), a1 + hstep, voffA);
            PG8_WAIT_V(8); PG8_WAIT_L(0); PG8_BAR; PG8_MMA(0, 0, At, B0); PG8_MMA(0, 1, At, B1); PG8_BAR; PG8_SCHED;
            PG8_LDA(At, 0, 1); PG8_STAGE(PG8_SB(0, 0), b2, voffB); PG8_STAGE(PG8_SB(0, 1), b2 + hstep, voffB); PG8_STAGE(PG8_SA(0, 0), a2, voffA);
            PG8_WAIT_V(8); PG8_WAIT_L(0); PG8_BAR; PG8_MMA(1, 0, At, B0); PG8_MMA(1, 1, At, B1); PG8_BAR; PG8_SCHED;
            PG8_LDB(B0, 1, 0); PG8_LDB(B1, 1, 1); PG8_SCHED; PG8_LDA(At, 1, 0); PG8_STAGE(PG8_SA(0, 1), a2 + hstep, voffA);
            PG8_WAIT_V(8); PG8_WAIT_L(0); PG8_BAR; PG8_MMA(0, 0, At, B0); PG8_MMA(0, 1, At, B1); PG8_BAR; PG8_SCHED;
            PG8_LDA(At, 1, 1); PG8_STAGE(PG8_SB(1, 0), b3, voffB); PG8_STAGE(PG8_SB(1, 1), b3 + hstep, voffB); PG8_STAGE(PG8_SA(1, 0), a3, voffA);
            PG8_WAIT_V(8); PG8_WAIT_L(0); PG8_BAR; PG8_MMA(1, 0, At, B0); PG8_MMA(1, 1, At, B1); PG8_BAR; PG8_SCHED;
        }
        if constexpr (ALIGN_EPI) { if (wr == 0) PG8_BAR; }
        if constexpr (!Epi::AFTER_DRAIN) { E.template run<2>(acc, cur.pm * BM, cur.pn, wr, wc, fr, fq); S.done(cur); }
        if (!has_next) break;
#pragma unroll
        for (int a = 0; a < 2; ++a)
#pragma unroll
            for (int b = 0; b < 2; ++b)
#pragma unroll
                for (int m = 0; m < 4; ++m)
#pragma unroll
                    for (int n = 0; n < 2; ++n) acc[a][b][m][n] = (f32x4){0.f, 0.f, 0.f, 0.f};
        cur = nxt; cA = nA; cB = nB; ++ui;
        if constexpr (ALIGN_EPI) { if (wr == 1) PG8_BAR; }
    }
    PG8_WAIT_V(0);
    if constexpr (!ALIGN_EPI) { if (wr == 0) PG8_BAR; }
    PG8_BAR;
    if constexpr (Epi::AFTER_DRAIN) { E.fused(acc, cur, wr, wc, fr, fq, lds, wid, lane); S.done(cur); }
#undef PG8_SA
#undef PG8_SB
#undef PG8_STAGE
#undef PG8_LDA
#undef PG8_LDB
#undef PG8_MMA
#undef PG8_WAIT_V
#undef PG8_WAIT_L
#undef PG8_BAR
#undef PG8_SCHED
}

template <class Epi>
__device__ __forceinline__ void gemm_half_phase(PG8_LAS unsigned char* lds, const bf16_t* Ah, const bf16_t* Bh, int K, int rowbase, int pn, const Epi& E) {
    int tid = threadIdx.x; asm volatile("" : "+v"(tid));
    const int wid = __builtin_amdgcn_readfirstlane(tid >> 6), lane = tid & 63, wr = wid >> 2, wc = wid & 3, fr = lane & 15, fq = lane >> 4;
    const int nt = K / BK;
    unsigned voffA[2], voffB[2];
#pragma unroll
    for (int i = 0; i < 2; ++i) { int R, C; stage_rc(tid * 16 + i * 8192, R, C); const int Rb = Epi::PERM ? ((R & ~31) + perm32(R & 31)) : R;
        voffA[i] = (unsigned)(R * K + C) * 2u; voffB[i] = (unsigned)(Rb * K + C) * 2u; }
    const size_t kstep = (size_t)(BK * 2);
    const size_t hstep = (size_t)HALF * K * 2;
    const unsigned ldsw = (unsigned)wid * 1024u;
    const int aoff = lds_byte(wr * 64 + fr, fq * 8), boff = lds_byte(wc * 32 + fr, fq * 8);
    constexpr int SST = 3 * HTB;
#define PH_STAGE(bufoff, gbase, voff) do { _Pragma("unroll") for (int _i = 0; _i < 2; ++_i) \
        __builtin_amdgcn_global_load_lds((const unsigned*)((const char*)(gbase) + (voff)[_i]), (PG8_LAS unsigned*)(lds + (bufoff) + ldsw + _i * 8192), 16, 0, 0); } while (0)
#define PH_STAGE_TILE(so, tt) do { PH_STAGE((so) + HTB, cB + (size_t)(tt) * kstep, voffB); PH_STAGE((so) + 2 * HTB, cB + hstep + (size_t)(tt) * kstep, voffB); PH_STAGE((so), cA + (size_t)(tt) * kstep, voffA); } while (0)
#define PH_LDA(dst, so) do { _Pragma("unroll") for (int m = 0; m < 4; ++m) _Pragma("unroll") for (int k = 0; k < 2; ++k) dst[m][k] = *(const PG8_LAS bf16x8*)(lds + (so) + aoff + m * 2048 + k * 1024); } while (0)
#define PH_LDB(dst, so, h) do { _Pragma("unroll") for (int n = 0; n < 2; ++n) _Pragma("unroll") for (int k = 0; k < 2; ++k) dst[n][k] = *(const PG8_LAS bf16x8*)(lds + (so) + HTB + (h) * HTB + boff + n * 2048 + k * 1024); } while (0)
#define PH_MMA(bj, At, Bt) do { __builtin_amdgcn_s_setprio(1); _Pragma("unroll") for (int m = 0; m < 4; ++m) _Pragma("unroll") for (int n = 0; n < 2; ++n) _Pragma("unroll") for (int k = 0; k < 2; ++k) \
        acc[0][bj][m][n] = __builtin_amdgcn_mfma_f32_16x16x32_bf16(Bt[n][k], At[m][k], acc[0][bj][m][n], 0, 0, 0); __builtin_amdgcn_s_setprio(0); } while (0)
#define PH_WAIT_V(n) asm volatile("s_waitcnt vmcnt(" #n ")" ::: "memory")
#define PH_WAIT_L(n) asm volatile("s_waitcnt lgkmcnt(" #n ")" ::: "memory")
#define PH_BAR __builtin_amdgcn_s_barrier()
#define PH_SCHED __builtin_amdgcn_sched_barrier(0)
    f32x4 acc[1][2][4][2];
#pragma unroll
    for (int b = 0; b < 2; ++b)
#pragma unroll
        for (int m = 0; m < 4; ++m)
#pragma unroll
            for (int n = 0; n < 2; ++n) acc[0][b][m][n] = (f32x4){0.f, 0.f, 0.f, 0.f};
    bf16x8 At[4][2], B0[2][2], B1[2][2];
    const char* cA = (const char*)Ah; const char* cB = (const char*)Bh;
    PH_STAGE_TILE(0, 0); PH_STAGE_TILE(SST, 1);
    if (wr == 1) PH_BAR;
    PH_WAIT_V(6); PH_BAR;
    PH_BAR;
    int so = 0, so2 = 2 * SST;
    for (int t = 0; t < nt; ++t) {
        const int t2 = (t + 2 < nt) ? t + 2 : t + 2 - nt;
        PH_LDB(B0, so, 0); PH_LDB(B1, so, 1); PH_SCHED; PH_LDA(At, so); PH_STAGE_TILE(so2, t2);
        PH_WAIT_V(6); PH_WAIT_L(0); PH_BAR; PH_MMA(0, At, B0); PH_MMA(1, At, B1); PH_BAR; PH_SCHED;
        so = (so == 2 * SST) ? 0 : so + SST; so2 = (so2 == 2 * SST) ? 0 : so2 + SST;
    }
    E.template run<1>(acc, rowbase, pn, wr, wc, fr, fq);
    PH_WAIT_V(0);
    if (wr == 0) PH_BAR;
    PH_BAR;
#undef PH_STAGE
#undef PH_STAGE_TILE
#undef PH_LDA
#undef PH_LDB
#undef PH_MMA
#undef PH_WAIT_V
#undef PH_WAIT_L
#undef PH_BAR
#undef PH_SCHED
}
}

__device__ __forceinline__ float wave_sum(float v) {
#pragma unroll
    for (int o = 1; o < 64; o <<= 1) v += __shfl_xor(v, o);
    return v;
}
template <bool GLU_PERM>
__device__ __forceinline__ void p0_transpose_item(const float* W, int K, int N, bf16_t* WT, LAS float* scr, int item, int lane) {
    const int nblk = N / 32, kb = item / nblk, nb = item % nblk, k0 = 64 * kb, n0 = 32 * nb;
    int d0 = n0;
    if (GLU_PERM) { if (n0 >= ZC_U1 && n0 < ZC_U2) { const int ch = n0 - ZC_U1; d0 = ZC_U1 + 256 * (ch >> 7) + (ch & 127); } else if (n0 >= ZC_U2 && n0 < ZC_GC) { const int ch = n0 - ZC_U2; d0 = ZC_U1 + 256 * (ch >> 7) + 128 + (ch & 127); } }
    float tv[32];
#pragma unroll
    for (int i = 0; i < 32; ++i) { const int kk = 2 * i + (lane >> 5); tv[i] = __builtin_nontemporal_load(W + (size_t)(k0 + kk) * N + n0 + (lane & 31)); }
#pragma unroll
    for (int i = 0; i < 32; ++i) { const int kk = 2 * i + (lane >> 5); scr[kk * 33 + (lane & 31)] = tv[i]; }
    asm volatile("s_waitcnt lgkmcnt(0)" ::: "memory");
    const int c = lane & 7;
#pragma unroll
    for (int j = 0; j < 4; ++j) { const int n = (lane >> 3) + 8 * j; const LAS float* s = scr + (8 * c) * 33 + n;
        u32x4 o; o.x = cvt_pk_bf16(s[0 * 33], s[1 * 33]); o.y = cvt_pk_bf16(s[2 * 33], s[3 * 33]); o.z = cvt_pk_bf16(s[4 * 33], s[5 * 33]); o.w = cvt_pk_bf16(s[6 * 33], s[7 * 33]);
        *(u32x4*)(WT + (size_t)(d0 + n) * K + k0 + 8 * c) = o; }
    asm volatile("s_waitcnt lgkmcnt(0)" ::: "memory");
}

struct Args {
    const float *x, *meta, *pre_w, *post_w, *w_in, *b_in, *lcw, *lcb, *wga, *bga, *wgx, *bgx, *lam, *cdw, *cdb, *clw, *clb, *cpw, *cpb, *w_out;
    float* out; unsigned char* ws;
};

__device__ __forceinline__ const bf16_t* zrow(const bf16_t* Z, int b, int hidx) { const int row = hidx < NMETA ? MX + hidx : b * SEQ + hidx - NMETA; return Z + (size_t)row * NIN; }

template <int N> struct RS {
    template <int MASK> static __device__ __forceinline__ void step(float (&v)[64], int lane) {
#pragma unroll
        for (int j = 0; j < N; ++j) { const float lo = v[j], hi = v[j + N]; const bool up = (lane & MASK) != 0; const float send = up ? lo : hi, keep = up ? hi : lo; v[j] = keep + __shfl_xor(send, MASK); }
    }
};

template <int RR> __device__ __forceinline__ void conv_row(f32x2 (&ac)[32], const f32x2 (&wk)[31], const LAS unsigned char* p) {
    const unsigned v = *(const LAS unsigned*)(p + RR * 2048); const f32x2 v2 = (f32x2){bf_lo(v), bf_hi(v)};
    constexpr int lo = RR - 30 > 0 ? RR - 30 : 0, hi = RR < 31 ? RR : 31;
#pragma unroll
    for (int o = lo; o <= hi; ++o) ac[o] = __builtin_elementwise_fma(wk[RR - o], v2, ac[o]);
}
template <int... R> __device__ __forceinline__ void conv_all(f32x2 (&ac)[32], const f32x2 (&wk)[31], const LAS unsigned char* p, std::integer_sequence<int, R...>) { (conv_row<R>(ac, wk, p), ...); }

__device__ __forceinline__ void conf_tile(const Args& A, const bf16_t* Z, bf16_t* VLN, LAS unsigned char* lds, int ti) {
    int tid = threadIdx.x; asm volatile("" : "+v"(tid));
    const int lane = tid & 63, wid = tid >> 6;
    const int b = ti >> 6, t0 = (ti & 63) * 32, i0 = NMETA + t0;
    LAS float* red = (LAS float*)(lds + 126976);
    LAS float* stats = (LAS float*)(lds + 129024);
    f32x2 wk[31];
    { const char* wp = (const char*)(A.cdw + 2 * tid);
#pragma unroll
      for (int k = 0; k < 31; ++k) { wk[k] = *(const f32x2*)wp; wp += DC * 4; asm volatile("" : "+v"(wp)); } }
    { u32x4 tv[16];
#pragma unroll
      for (int it = 0; it < 16; ++it) { const int idx = tid + 512 * it; const int rr = idx >> 7, c8 = idx & 127; const int hidx = i0 - 30 + rr;
          tv[it] = (u32x4){0u, 0u, 0u, 0u};
          if (idx < 62 * 128 && hidx >= 0) tv[it] = *(const u32x4*)(zrow(Z, b, hidx) + ZC_U1 + 8 * c8); }
#pragma unroll
      for (int it = 0; it < 16; ++it) { const int idx = tid + 512 * it; const int rr = idx >> 7, c8 = idx & 127;
          if (idx < 62 * 128) *(LAS u32x4*)(lds + rr * 2048 + c8 * 16) = tv[it]; } }
    __syncthreads();
    f32x2 ac[32];
    { const f32x2 bb = *(const f32x2*)(A.cdb + 2 * tid);
#pragma unroll
      for (int o = 0; o < 32; ++o) ac[o] = bb; }
    conv_all(ac, wk, lds + tid * 4, std::make_integer_sequence<int, 62>{});
    float v[64];
#pragma unroll
    for (int o = 0; o < 32; ++o) { v[2 * o] = ac[o].x + ac[o].y; v[2 * o + 1] = ac[o].x * ac[o].x + ac[o].y * ac[o].y; }
    RS<32>::step<32>(v, lane); RS<16>::step<16>(v, lane); RS<8>::step<8>(v, lane); RS<4>::step<4>(v, lane); RS<2>::step<2>(v, lane); RS<1>::step<1>(v, lane);
    red[wid * 64 + lane] = v[0];
    __syncthreads();
    if (tid < 64) { float s = 0.f;
#pragma unroll
        for (int w = 0; w < 8; ++w) s += red[w * 64 + tid];
        red[tid] = s; }
    __syncthreads();
    if (tid < 32) { const float s1 = red[2 * tid], s2 = red[2 * tid + 1]; const float mean = s1 * (1.0f / DC); const float var = s2 * (1.0f / DC) - mean * mean;
        stats[2 * tid] = mean; stats[2 * tid + 1] = 1.0f / sqrtf(fmaxf(var, 0.f) + EPS); }
    __syncthreads();
    const f32x2 lw = *(const f32x2*)(A.clw + 2 * tid), lb = *(const f32x2*)(A.clb + 2 * tid);
    unsigned* op = (unsigned*)(VLN + (size_t)(b * SEQ + t0) * DC + 2 * tid);
#pragma unroll
    for (int o = 0; o < 32; ++o) { const float mean = stats[2 * o], rstd = stats[2 * o + 1];
        const float y0 = (ac[o].x - mean) * rstd * lw.x + lb.x, y1 = (ac[o].y - mean) * rstd * lw.y + lb.y;
        op[(size_t)o * (DC / 2)] = cvt_pk_bf16(siluf(y0), siluf(y1)); }
    __syncthreads();
}

constexpr int L_WL = 0, L_CW = 16384, L_CST = 17664, L_XT = 18688, XT_STRIDE = 144, XT_BYTES = 16 * XT_STRIDE, L_WT = L_XT + 8 * XT_BYTES;
static_assert(L_WT == 37120, "lds map");
constexpr int L_XS = L_WT + 4096, XS_STRIDE = 144, XS_ROWS = 515, L_YT = L_XS, YT_STRIDE = 144, YT_BYTES = 64 * YT_STRIDE;
static_assert(L_XS + XS_ROWS * XS_STRIDE <= 131072 && L_YT + 8 * YT_BYTES <= 131072 && 61 * XS_STRIDE >= 8448, "lds map");

template <bool STASH, bool FROM_LDS>
__device__ __forceinline__ void lru_mtile(const bf16_t* Z, int b, int h, int hb, const LAS unsigned char* xs, LAS unsigned char* lds, LAS unsigned char* xt, int lane,
                                          float (&cP)[4], float (&cH)[4], float (&sH)[4][4], float (&sP)[4][4]) {
    const int r = lane & 15, kq = lane >> 4;
    const LAS float* cw = (const LAS float*)(lds + L_CW);
    const LAS float* cst = (const LAS float*)(lds + L_CST);
    float xc[2][8];
#pragma unroll
    for (int ks = 0; ks < 2; ++ks) { const f32x4 b0 = *(const LAS f32x4*)(cw + 4 * 64 + 32 * ks + 8 * kq), b1 = *(const LAS f32x4*)(cw + 4 * 64 + 32 * ks + 8 * kq + 4);
        xc[ks][0] = b0[0]; xc[ks][1] = b0[1]; xc[ks][2] = b0[2]; xc[ks][3] = b0[3]; xc[ks][4] = b1[0]; xc[ks][5] = b1[1]; xc[ks][6] = b1[2]; xc[ks][7] = b1[3]; }
#pragma unroll
    for (int k = 0; k < 4; ++k) { const int hidx = hb + r - 3 + k;
        if (FROM_LDS || hidx >= 0) { const bf16_t* rp = zrow(Z, b, hidx < 0 ? 0 : hidx) + ZC_XL + 64 * h + 8 * kq;
#pragma unroll
            for (int ks = 0; ks < 2; ++ks) { u32x4 v;
                if (FROM_LDS) v = *(const LAS u32x4*)(xs + (r + k) * XS_STRIDE + (8 * kq + 32 * ks) * 2); else v = *(const u32x4*)(rp + 32 * ks);
                const f32x4 w0 = *(const LAS f32x4*)(cw + k * 64 + 32 * ks + 8 * kq), w1 = *(const LAS f32x4*)(cw + k * 64 + 32 * ks + 8 * kq + 4);
                xc[ks][0] += w0[0] * bf_lo(v.x); xc[ks][1] += w0[1] * bf_hi(v.x); xc[ks][2] += w0[2] * bf_lo(v.y); xc[ks][3] += w0[3] * bf_hi(v.y);
                xc[ks][4] += w1[0] * bf_lo(v.z); xc[ks][5] += w1[1] * bf_hi(v.z); xc[ks][6] += w1[2] * bf_lo(v.w); xc[ks][7] += w1[3] * bf_hi(v.w); } } }
    bf16x8 af[2];
#pragma unroll
    for (int ks = 0; ks < 2; ++ks) { u32x4 p; p.x = cvt_pk_bf16(xc[ks][0], xc[ks][1]); p.y = cvt_pk_bf16(xc[ks][2], xc[ks][3]); p.z = cvt_pk_bf16(xc[ks][4], xc[ks][5]); p.w = cvt_pk_bf16(xc[ks][6], xc[ks][7]);
        af[ks] = __builtin_bit_cast(bf16x8, p); *(LAS u32x4*)(xt + r * XT_STRIDE + (32 * ks + 8 * kq) * 2) = p; }
    asm volatile("s_waitcnt lgkmcnt(0)" ::: "memory");
    __builtin_amdgcn_wave_barrier();
#pragma unroll
    for (int ct = 0; ct < 4; ++ct) {
        const bf16x8 wa0 = *(const LAS bf16x8*)(lds + L_WL + ((0 * 4 + ct) * 2 + 0) * 1024 + lane * 16), wa1 = *(const LAS bf16x8*)(lds + L_WL + ((0 * 4 + ct) * 2 + 1) * 1024 + lane * 16);
        const bf16x8 wx0 = *(const LAS bf16x8*)(lds + L_WL + ((1 * 4 + ct) * 2 + 0) * 1024 + lane * 16), wx1 = *(const LAS bf16x8*)(lds + L_WL + ((1 * 4 + ct) * 2 + 1) * 1024 + lane * 16);
        f32x4 ra = (f32x4){0.f, 0.f, 0.f, 0.f}, ia = (f32x4){0.f, 0.f, 0.f, 0.f};
        ra = __builtin_amdgcn_mfma_f32_16x16x32_bf16(af[0], wa0, ra, 0, 0, 0); ra = __builtin_amdgcn_mfma_f32_16x16x32_bf16(af[1], wa1, ra, 0, 0, 0);
        ia = __builtin_amdgcn_mfma_f32_16x16x32_bf16(af[0], wx0, ia, 0, 0, 0); ia = __builtin_amdgcn_mfma_f32_16x16x32_bf16(af[1], wx1, ia, 0, 0, 0);
        const f32x4 c4 = *(const LAS f32x4*)(cst + (16 * ct + r) * 4);
        float p[4], hh[4];
#pragma unroll
        for (int j = 0; j < 4; ++j) {
            const float xcv = __uint_as_float((unsigned)(*(const LAS unsigned short*)(xt + (4 * kq + j) * XT_STRIDE + (16 * ct + r) * 2)) << 16);
            const float rr = __builtin_amdgcn_rcpf(1.0f + __builtin_amdgcn_exp2f(__builtin_fmaf(ra[j], -1.44269504f, c4[0])));
            const float ii = __builtin_amdgcn_rcpf(1.0f + __builtin_amdgcn_exp2f(__builtin_fmaf(ia[j], -1.44269504f, c4[1])));
            const float a = __builtin_amdgcn_exp2f(c4[2] * rr);
            const float x2 = c4[3] * rr;
            float om_p = -x2 * __builtin_fmaf(x2, 0.5f, 1.0f), om_b = __builtin_fmaf(-a, a, 1.0f); asm volatile("" : "+v"(om_p), "+v"(om_b));
            const float om = x2 > -2e-3f ? om_p : om_b;
            const float mult = __builtin_amdgcn_sqrtf(om); const float u = mult * ii * xcv;
            if (j == 0) { p[0] = a; hh[0] = u; } else { p[j] = p[j - 1] * a; hh[j] = hh[j - 1] * a + u; } }
        float EP = cP[ct], EH = cH[ct];
#pragma unroll
        for (int q = 0; q < 3; ++q) { float tp = __shfl(p[3], r + 16 * q), th = __shfl(hh[3], r + 16 * q); tp = q < kq ? tp : 1.0f; th = q < kq ? th : 0.0f; EH = EH * tp + th; EP = EP * tp; }
        if (STASH) {
#pragma unroll
            for (int j = 0; j < 4; ++j) { sH[ct][j] = EH * p[j] + hh[j]; sP[ct][j] = EP * p[j]; } }
        const float tP = EP * p[3], tH = EH * p[3] + hh[3];
        cP[ct] = __shfl(tP, r + 48); cH[ct] = __shfl(tH, r + 48);
        if (ct & 1) __builtin_amdgcn_sched_barrier(0);
    }
    __builtin_amdgcn_wave_barrier();
}

__device__ __forceinline__ void lru_fill_tables(const Args& A, int uh, LAS unsigned char* lds, int tid) {
    for (int f = tid; f < 1024; f += 512) { const int l = f & 63, ks = (f >> 6) & 1, ct = (f >> 7) & 3, gsel = f >> 9; const int n = l & 15, kq = l >> 4;
        const float* wsrc = (gsel ? A.wgx : A.wga) + (size_t)uh * 4096 + (size_t)(32 * ks + 8 * kq) * 64 + 16 * ct + n;
        u32x4 p; p.x = cvt_pk_bf16(wsrc[0], wsrc[64]); p.y = cvt_pk_bf16(wsrc[128], wsrc[192]); p.z = cvt_pk_bf16(wsrc[256], wsrc[320]); p.w = cvt_pk_bf16(wsrc[384], wsrc[448]);
        *(LAS u32x4*)(lds + L_WL + ((gsel * 4 + ct) * 2 + ks) * 1024 + l * 16) = p; }
    if (tid < 320) { const int k = tid >> 6, c = tid & 63; ((LAS float*)(lds + L_CW))[tid] = k < 4 ? A.lcw[k * DL + 64 * uh + c] : A.lcb[64 * uh + c]; }
    if (tid < 64) { const int c = 64 * uh + tid; const float lm = A.lam[c]; const float sp = (-lm > 20.f) ? -lm : log1pf(__expf(-lm));
        *(LAS f32x4*)(lds + L_CST + tid * 16) = (f32x4){-1.44269504f * A.bga[c], -1.44269504f * A.bgx[c], -8.0f * sp * 1.44269504f, -16.0f * sp}; }
}

__global__ void __launch_bounds__(512, 2) mega(Args A) {
    extern __shared__ __attribute__((aligned(16))) unsigned char lds_raw[];
    LAS unsigned char* lds = (LAS unsigned char*)lds_raw;
    unsigned* const bwords = (unsigned*)(A.ws + WS_CTL) + 1024;
    unsigned* const iflag = (unsigned*)(A.ws + WS_CTL); unsigned* const idone = iflag + 64; unsigned* const pcnt = iflag + 8192;
    if (threadIdx.x < 2) ((volatile LAS unsigned*)(lds + L_MISC))[threadIdx.x] = 0u;
    if (blockIdx.x == 0 && threadIdx.x < 64) {
        const int l = threadIdx.x;
        if (l < 16) { __hip_atomic_store(&bwords[XB_XCNT(l)], 0u, __ATOMIC_RELAXED, __HIP_MEMORY_SCOPE_AGENT); __hip_atomic_store(&bwords[XB_XSUB(l)], 0u, __ATOMIC_RELAXED, __HIP_MEMORY_SCOPE_AGENT);
                      __hip_atomic_store(&bwords[XB_XGEN(l)], 0u, __ATOMIC_RELAXED, __HIP_MEMORY_SCOPE_AGENT); }
        if (l == 16) __hip_atomic_store(&bwords[XB_TOP], 0u, __ATOMIC_RELAXED, __HIP_MEMORY_SCOPE_AGENT);
        if (l == 17) __hip_atomic_store(&bwords[XB_TOPGEN], 0u, __ATOMIC_RELAXED, __HIP_MEMORY_SCOPE_AGENT);
        if (l == 18) __hip_atomic_store(&bwords[XB_TMO], 0u, __ATOMIC_RELAXED, __HIP_MEMORY_SCOPE_AGENT);
        if (l == 19) __hip_atomic_store(idone, 0u, __ATOMIC_RELAXED, __HIP_MEMORY_SCOPE_AGENT);
        if (l >= 32) __hip_atomic_store(pcnt + 64 * (l - 32), 0u, __ATOMIC_RELAXED, __HIP_MEMORY_SCOPE_AGENT);
        asm volatile("s_waitcnt vmcnt(0)" ::: "memory");
        __builtin_amdgcn_fence(__ATOMIC_RELEASE, "agent");
        asm volatile("s_waitcnt vmcnt(0)" ::: "memory");
        if (l == 0) __hip_atomic_store(iflag, INIT_TOKEN, __ATOMIC_RELEASE, __HIP_MEMORY_SCOPE_AGENT);
    }
    __syncthreads();
    const int G = gridDim.x, bx = blockIdx.x;
#define PHASE_IDS() int tid = threadIdx.x; asm volatile("" : "+v"(tid)); const int lane = tid & 63, wid = __builtin_amdgcn_readfirstlane(tid >> 6); (void)lane; (void)wid
    unsigned char* ws = A.ws;
    bf16_t* W1T = (bf16_t*)(ws + WS_W1T); bf16_t* W3T = (bf16_t*)(ws + WS_W3T); bf16_t* WPT = (bf16_t*)(ws + WS_WPT);
    bf16_t* HN = (bf16_t*)(ws + WS_HN); bf16_t* Z = (bf16_t*)(ws + WS_Z); bf16_t* VLN = (bf16_t*)(ws + WS_VLN); bf16_t* Y = (bf16_t*)(ws + WS_Y);
    float* PART = (float*)(ws + WS_PART); f32x2* CARRY = (f32x2*)(ws + WS_CARRY); float* HMETA = (float*)(ws + WS_CARRY + 512 * 1024);

    for (int rep = 0; rep <= PROBE_P0; ++rep) {
        PHASE_IDS();
        LAS float* scr = (LAS float*)(lds + wid * 8448);
        const int gw = bx * 8 + wid, NGW = G * 8;
        constexpr int I1 = (DM / 64) * (NIN / 32);
        for (int it = gw; it < I1; it += NGW) p0_transpose_item<true>(A.w_in, DM, NIN, W1T, scr, it, lane);
        for (int m = gw; m < MX + NMETA; m += NGW) {
            u32x2* o8 = (u32x2*)(HN + (size_t)m * DM) + lane;
            if (m >= MX + NMETA) {
#pragma unroll
                for (int j = 0; j < 8; ++j) o8[64 * j] = (u32x2){0u, 0u};
                continue; }
            const float* src = m < MX ? A.x + (size_t)m * DM : A.meta + (size_t)(m - MX) * DM;
            const f32x4* s4 = (const f32x4*)src + lane; f32x4 v[8]; float ss = 0.f;
#pragma unroll
            for (int j = 0; j < 8; ++j) { v[j] = __builtin_nontemporal_load(s4 + 64 * j); ss += (v[j][0] * v[j][0] + v[j][1] * v[j][1]) + (v[j][2] * v[j][2] + v[j][3] * v[j][3]); }
            const float rstd = 1.0f / sqrtf(wave_sum(ss) * (1.0f / DM) + EPS);
            const f32x4* w4 = (const f32x4*)A.pre_w + lane;
#pragma unroll
            for (int j = 0; j < 8; ++j) { const f32x4 w = w4[64 * j]; o8[64 * j] = (u32x2){cvt_pk_bf16(v[j][0] * rstd * w[0], v[j][1] * rstd * w[1]), cvt_pk_bf16(v[j][2] * rstd * w[2], v[j][3] * rstd * w[3])}; }
        }
    }
    if (threadIdx.x == 0) { unsigned sp = 0; while (__hip_atomic_load(iflag, __ATOMIC_RELAXED, __HIP_MEMORY_SCOPE_AGENT) != INIT_TOKEN) { __builtin_amdgcn_s_sleep(2); if (++sp > (1u << 22)) break; }
        __builtin_amdgcn_fence(__ATOMIC_ACQUIRE, "agent"); }
    __syncthreads();
    const XcdBarrier gbar = xcd_barrier_post(bwords, (volatile LAS unsigned*)(lds + L_MISC));
    xcd_barrier(gbar);
    for (int rep = 0; rep < PROBE_SYNC; ++rep) xcd_barrier(gbar);

    for (int rep = 0; rep <= PROBE_P1; ++rep) {
        {
            PHASE_IDS();
            const int r = lane & 15, kq = lane >> 4; const int job = bx; const bool glu = job >= 192;
            int n1, n2 = 0;
            if (!glu) n1 = 16 * job < ZC_U1 ? 16 * job : 16 * job + 2048;
            else { const int ch0 = 16 * (job - 192); n1 = ZC_U1 + 256 * (ch0 >> 7) + (ch0 & 127); n2 = n1 + 128; }
            const bf16_t* ap = HN + (size_t)(MX + r) * DM + 8 * kq + 256 * wid;
            const bf16_t* bp1 = W1T + (size_t)(n1 + r) * DM + 8 * kq + 256 * wid; const bf16_t* bp2 = W1T + (size_t)(n2 + r) * DM + 8 * kq + 256 * wid;
            f32x4 c1 = (f32x4){0.f, 0.f, 0.f, 0.f}, c2 = (f32x4){0.f, 0.f, 0.f, 0.f};
            const int mch = 16 * (job - 192) + r;
            const float mb1 = glu ? A.b_in[ZC_U1 + mch] : A.b_in[n1 + r], mb2 = glu ? A.b_in[ZC_U2 + mch] : 0.f;
            if (job < 256) {
#pragma unroll
                for (int ks = 0; ks < 8; ++ks) { const bf16x8 av = *(const bf16x8*)(ap + 32 * ks); const bf16x8 b1 = *(const bf16x8*)(bp1 + 32 * ks);
                    c1 = __builtin_amdgcn_mfma_f32_16x16x32_bf16(av, b1, c1, 0, 0, 0);
                    if (glu) { const bf16x8 b2 = *(const bf16x8*)(bp2 + 32 * ks); c2 = __builtin_amdgcn_mfma_f32_16x16x32_bf16(av, b2, c2, 0, 0, 0); } }
                LAS f32x4* red = (LAS f32x4*)lds;
                red[(wid * 2 + 0) * 64 + lane] = c1; red[(wid * 2 + 1) * 64 + lane] = c2;
            }
            __syncthreads();
            if (job < 256 && wid == 0) { const LAS f32x4* red = (const LAS f32x4*)lds; f32x4 t1 = red[lane], t2 = red[64 + lane];
#pragma unroll
                for (int w = 1; w < 8; ++w) { t1 += red[(w * 2 + 0) * 64 + lane]; t2 += red[(w * 2 + 1) * 64 + lane]; }
                if (!glu) { const float bb = mb1;
#pragma unroll
                    for (int j = 0; j < 4; ++j) Z[(size_t)(MX + 4 * kq + j) * NIN + n1 + r] = (bf16_t)(cvt_pk_bf16(t1[j] + bb, 0.f) & 0xffffu); }
                else { const int ch = mch; const float b1 = mb1, b2 = mb2;
#pragma unroll
                    for (int j = 0; j < 4; ++j) Z[(size_t)(MX + 4 * kq + j) * NIN + ZC_U1 + ch] = (bf16_t)(cvt_pk_bf16((t1[j] + b1) * sigm(t2[j] + b2), 0.f) & 0xffffu); } }
            __syncthreads();
        }
        { pg8::EpiZ E{Z, NIN, A.b_in, 0}; pg8::StaticOrder S; S.init(MX, ZC_GC, G, bx);
          pg8::Gemm g{HN, W1T, MX, ZC_GC, DM}; pg8::gemm_phase<pg8::EpiZ, pg8::StaticOrder, true>(lds, g, S, E); }
    }
    xcd_barrier(gbar);

    if (2 * (MX / 256) * ((NIN - ZC_GC) / 256) == G) {
        if (bx < G / 2) { pg8::EpiZ E{Z, NIN, A.b_in, ZC_GC / 256}; pg8::StaticOrder S; S.init(MX, NIN - ZC_GC, G / 2, bx);
            pg8::Gemm g{HN, W1T + (size_t)ZC_GC * DM, MX, NIN - ZC_GC, DM}; pg8::gemm_phase<pg8::EpiZ, pg8::StaticOrder, true>(lds, g, S, E); }
        else { { const int j = bx - G / 2, t = (j & 7) * (G / 16) + (j >> 3);
                 for (int ti = t; ti < MX / 32; ti += G / 2) conf_tile(A, Z, VLN, lds, ti); }
            if (bx - G / 2 < 16) { PHASE_IDS(); const int mh = bx - G / 2;
                lru_fill_tables(A, mh, lds, tid);
                __syncthreads();
                if (wid == 0) { float cP[4] = {1.f, 1.f, 1.f, 1.f}, cH[4] = {0.f, 0.f, 0.f, 0.f}; float dH[4][4], dP[4][4];
                    lru_mtile<false, false>(Z, 0, mh, 0, lds, lds, lds + L_XT, lane, cP, cH, dH, dP);
                    if (lane < 16) {
#pragma unroll
                        for (int ct = 0; ct < 4; ++ct) HMETA[mh * 64 + 16 * ct + lane] = cH[ct]; } }
                __syncthreads(); }
            else { PHASE_IDS();
                LAS float* scr = (LAS float*)(lds + wid * 8448);
                const int gw = (bx - G / 2 - 16) * 8 + wid, NGW = (G / 2 - 16) * 8;
                constexpr int I3 = (DM / 64) * (DM / 32), IP = (DC / 64) * (DC / 32);
                for (int it = gw; it < I3 + IP; it += NGW) { if (it < I3) p0_transpose_item<false>(A.w_out, DM, DM, W3T, scr, it, lane); else p0_transpose_item<false>(A.cpw, DC, DC, WPT, scr, it - I3, lane); } } }
    } else {
        { pg8::EpiZ E{Z, NIN, A.b_in, ZC_GC / 256}; pg8::StaticOrder S; S.init(MX, NIN - ZC_GC, G, bx);
          pg8::Gemm g{HN, W1T + (size_t)ZC_GC * DM, MX, NIN - ZC_GC, DM}; pg8::gemm_phase<pg8::EpiZ, pg8::StaticOrder, true>(lds, g, S, E); }
        for (int ti = bx; ti < MX / 32; ti += G) conf_tile(A, Z, VLN, lds, ti);
    }
    __syncthreads();

    const int ub = bx >> 6, uh = (bx >> 2) & 15, uq = bx & 3;
    float sH[4][4][4], sP[4][4][4];
    for (int rep = 0; rep <= PROBE_P2B; ++rep) {
        if (rep) __syncthreads();
        PHASE_IDS();
        { u32x4 tv[9];
#pragma unroll
          for (int it = 0; it < 9; ++it) { const int idx = tid + 512 * it; const int row = idx >> 3, c = idx & 7; tv[it] = (u32x4){0u, 0u, 0u, 0u};
              if (idx < XS_ROWS * 8) tv[it] = *(const u32x4*)(zrow(Z, ub, NMETA + 512 * uq - 3 + row) + ZC_XL + 64 * uh + 8 * c); }
#pragma unroll
          for (int it = 0; it < 9; ++it) { const int idx = tid + 512 * it; const int row = idx >> 3, c = idx & 7;
              if (idx < XS_ROWS * 8) *(LAS u32x4*)(lds + L_XS + row * XS_STRIDE + c * 16) = tv[it]; } }
        lru_fill_tables(A, uh, lds, tid);
        __syncthreads();
        LAS unsigned char* xt = lds + L_XT + wid * XT_BYTES;
        float cP[4] = {1.f, 1.f, 1.f, 1.f}, cH[4] = {0.f, 0.f, 0.f, 0.f};
        const int hb0 = NMETA + 512 * uq + 64 * wid;
#pragma unroll
        for (int mt = 0; mt < 4; ++mt) lru_mtile<true, true>(Z, ub, uh, hb0 + 16 * mt, lds + L_XS + (64 * wid + 16 * mt) * XS_STRIDE, lds, xt, lane, cP, cH, sH[mt], sP[mt]);
        LAS f32x2* wt = (LAS f32x2*)(lds + L_WT);
        if (lane < 16) {
#pragma unroll
            for (int ct = 0; ct < 4; ++ct) wt[wid * 64 + 16 * ct + lane] = (f32x2){cP[ct], cH[ct]}; }
        __syncthreads();
        if (tid < 64) { float P = 1.f, H = 0.f;
#pragma unroll
            for (int w = 0; w < 8; ++w) { const f32x2 t = wt[w * 64 + tid]; H = H * t.x + t.y; P = P * t.x; }
            CARRY[((ub * 16 + uh) * 4 + uq) * 64 + tid] = (f32x2){P, H}; }
    }
    xcd_barrier(gbar);

    {
        PHASE_IDS();
        const LAS f32x2* wt = (const LAS f32x2*)(lds + L_WT);
        LAS unsigned char* yt = lds + L_YT + wid * YT_BYTES;
        const int r = lane & 15, kq = lane >> 4;
#pragma unroll
        for (int ct = 0; ct < 4; ++ct) { const int c = 16 * ct + r; float hin = HMETA[uh * 64 + c];
            for (int q = 0; q < uq; ++q) { const f32x2 t = CARRY[((ub * 16 + uh) * 4 + q) * 64 + c]; hin = hin * t.x + t.y; }
            for (int w = 0; w < wid; ++w) { const f32x2 t = wt[w * 64 + c]; hin = hin * t.x + t.y; }
#pragma unroll
            for (int mt = 0; mt < 4; ++mt)
#pragma unroll
                for (int j = 0; j < 4; ++j) { const float hv = sH[mt][ct][j] + sP[mt][ct][j] * hin;
                    *(LAS unsigned short*)(yt + (16 * mt + 4 * kq + j) * YT_STRIDE + c * 2) = (unsigned short)(cvt_pk_bf16(hv, 0.f) & 0xffffu); } }
        asm volatile("s_waitcnt lgkmcnt(0)" ::: "memory");
        __builtin_amdgcn_wave_barrier();
#pragma unroll
        for (int i = 0; i < 8; ++i) { const int piece = lane + 64 * i, tl = piece >> 3, c8 = piece & 7;
            const u32x4 hv = *(const LAS u32x4*)(yt + tl * YT_STRIDE + c8 * 16);
            const size_t row = (size_t)ub * SEQ + 512 * uq + 64 * wid + tl;
            const u32x4 g = *(const u32x4*)(Z + row * NIN + ZC_GL + 64 * uh + 8 * c8);
            u32x4 o;
            o.x = cvt_pk_bf16(bf_lo(hv.x) * siluf(bf_lo(g.x)), bf_hi(hv.x) * siluf(bf_hi(g.x)));
            o.y = cvt_pk_bf16(bf_lo(hv.y) * siluf(bf_lo(g.y)), bf_hi(hv.y) * siluf(bf_hi(g.y)));
            o.z = cvt_pk_bf16(bf_lo(hv.z) * siluf(bf_lo(g.z)), bf_hi(hv.z) * siluf(bf_hi(g.z)));
            o.w = cvt_pk_bf16(bf_lo(hv.w) * siluf(bf_lo(g.w)), bf_hi(hv.w) * siluf(bf_hi(g.w)));
            *(u32x4*)(Y + row * DM + 64 * uh + 8 * c8) = o; }
    }
    __syncthreads();

    for (int rep = 0; rep <= PROBE_P3; ++rep) {
        pg8::EpiPW E{Y, Z, A.cpb};
        pg8::StaticOrder S; S.init(MX, DC, G, bx);
        if (2 * S.nwg == G) { pg8::Unit u; S.at((bx & 7) + 8 * (bx >> 4), u); const int rowbase = u.pm * 256 + 128 * ((bx >> 3) & 1);
            pg8::gemm_half_phase<pg8::EpiPW>(lds, VLN + (size_t)rowbase * DC, WPT + (size_t)u.pn * 256 * DC, DC, rowbase, u.pn, E); }
        else { pg8::Gemm g{VLN, WPT, MX, DC, DC}; pg8::gemm_phase<pg8::EpiPW, pg8::StaticOrder, true>(lds, g, S, E); }
    }
    xcd_barrier(gbar);

    {
        pg8::Gemm g{Y, W3T, MX, DM, DM}; pg8::StaticOrder S; S.init(MX, DM, G, bx);
        pg8::EpiOut E{A.x, A.out, A.post_w, PART, pcnt};
        pg8::gemm_phase<pg8::EpiOut, pg8::StaticOrder, false>(lds, g, S, E);
    }
    __syncthreads();
    if (threadIdx.x == 0) { const unsigned old = __hip_atomic_fetch_add(idone, 1u, __ATOMIC_RELAXED, __HIP_MEMORY_SCOPE_AGENT); if (old + 1u == (unsigned)G) __hip_atomic_store(iflag, 0u, __ATOMIC_RELAXED, __HIP_MEMORY_SCOPE_AGENT); }
}

extern "C" void kernel_launch(void* const* d_in, const int* in_sizes, int n_in, void* d_out, int out_size, void* d_ws, size_t ws_size, hipStream_t stream) {
    static int grid = 0;
    if (grid == 0) {
        if (n_in != 20 || out_size != MX * DM || ws_size < WS_END) { fprintf(stderr, "kernel_launch: unexpected problem shape (n_in %d out %d ws %zu)\n", n_in, out_size, ws_size); grid = -1; return; }
        int dev = 0, cus = 0, per_cu = 0;
        hipGetDevice(&dev); hipDeviceGetAttribute(&cus, hipDeviceAttributeMultiprocessorCount, dev);
        if (hipFuncSetAttribute((const void*)mega, hipFuncAttributeMaxDynamicSharedMemorySize, LDS_BYTES) != hipSuccess) { fprintf(stderr, "kernel_launch: hipFuncSetAttribute failed\n"); grid = -1; return; }
        hipOccupancyMaxActiveBlocksPerMultiprocessor(&per_cu, (const void*)mega, 512, LDS_BYTES);
        if (cus * per_cu < 256) { fprintf(stderr, "kernel_launch: need 256 resident workgroups, device offers %d x %d\n", cus, per_cu); grid = -1; return; }
        grid = 256;
    }
    if (grid < 0) return;
    Args a{};
    const float** ap = (const float**)&a;
    for (int i = 0; i < 20; ++i) ap[i] = (const float*)d_in[i];
    a.out = (float*)d_out; a.ws = (unsigned char*)d_ws;
    void* args[] = {&a};
    hipError_t e = hipLaunchCooperativeKernel((const void*)mega, dim3(grid), dim3(512), args, LDS_BYTES, stream);
    if (e != hipSuccess) fprintf(stderr, "cooperative launch failed: %s\n", hipGetErrorString(e));
}
```

```cpp
#include <hip/hip_runtime.h>
#include <cstdio>
#include <cstdint>
#include <utility>

#define LAS __attribute__((address_space(3)))
typedef unsigned short bf16_t;
typedef short bf16x8 __attribute__((ext_vector_type(8)));
typedef float f32x4 __attribute__((ext_vector_type(4)));
typedef float f32x2 __attribute__((ext_vector_type(2)));
typedef unsigned u32x4 __attribute__((ext_vector_type(4)));
typedef unsigned u32x2 __attribute__((ext_vector_type(2)));

constexpr int DM = 2048, NBATCH = 4, SEQ = 2048, NMETA = 16, MX = NBATCH * SEQ  , MPAD = MX + 256  , NIN = 5120, DL = 1024, DC = 1024;
constexpr int ZC_XL = 0, ZC_GL = 1024, ZC_U1 = 2048, ZC_U2 = 3072, ZC_GC = 4096;
constexpr float EPS = 1e-6f;
constexpr size_t MiB = 1u << 20;
constexpr size_t WS_W1T = 1 * MiB;
constexpr size_t WS_W3T = 22 * MiB;
constexpr size_t WS_WPT = 30 * MiB;
constexpr size_t WS_HN = 32 * MiB;
constexpr size_t WS_Z = 66 * MiB;
constexpr size_t WS_VLN = 150 * MiB;
constexpr size_t WS_Y = 166 * MiB;
constexpr size_t WS_PART = 198 * MiB;
constexpr size_t WS_CARRY = 199 * MiB;
constexpr size_t WS_END = 200 * MiB;
static_assert(WS_W1T + (size_t)NIN * DM * 2 <= WS_W3T && WS_HN + (size_t)MPAD * DM * 2 <= WS_Z && WS_Z + (size_t)MPAD * NIN * 2 <= WS_VLN, "ws map");
constexpr int LDS_BYTES = 149504, L_MISC = 148480;
constexpr size_t WS_CTL = 0, CTL_BYTES = 32768;
constexpr unsigned INIT_TOKEN = 0x5EEDC0DEu;
constexpr int PROBE_SYNC = 0, PROBE_P0 = 0, PROBE_P1 = 0, PROBE_P2B = 0, PROBE_P3 = 0;

__device__ __forceinline__ unsigned cvt_pk_bf16(float lo, float hi) { unsigned r; asm volatile("v_cvt_pk_bf16_f32 %0, %1, %2" : "=v"(r) : "v"(lo), "v"(hi)); return r; }
__device__ __forceinline__ float bf_lo(unsigned w) { return __uint_as_float(w << 16); }
__device__ __forceinline__ float bf_hi(unsigned w) { return __uint_as_float(w & 0xffff0000u); }
__device__ __forceinline__ float sigm(float x) { return __builtin_amdgcn_rcpf(1.0f + __expf(-x)); }
__device__ __forceinline__ float siluf(float x) { return x * sigm(x); }


#define XB_TMO      128
#define XB_XCNT(j)  (256  + 64 * (j))
#define XB_XSUB(j)  (1280 + 64 * (j))
#define XB_XGEN(j)  (2304 + 64 * (j))
#define XB_TOP      3328
#define XB_TOPGEN   3392
#define XCD_BAR_WORDS 3456
#define XB_SPIN_CAP (1u << 18)
__device__ __forceinline__ unsigned xb_ld(unsigned* p)              { return __hip_atomic_load(p, __ATOMIC_RELAXED, __HIP_MEMORY_SCOPE_AGENT); }
__device__ __forceinline__ unsigned xb_add(unsigned* p, unsigned v) { return __hip_atomic_fetch_add(p, v, __ATOMIC_RELAXED, __HIP_MEMORY_SCOPE_AGENT); }
__device__ __forceinline__ unsigned xb_xcc_id() { return (unsigned)__builtin_amdgcn_s_getreg((3 << 11) | 20) & 0xFu; }
#define XB_SPIN(cond, bar) do { unsigned _sp = 0; while (cond) { __builtin_amdgcn_s_sleep(1); \
    if ((++_sp & 255u) == 0u) { if (xb_ld(&(bar)[XB_TMO])) break; if (_sp > XB_SPIN_CAP) { atomicAdd(&(bar)[XB_TMO], 1u); break; } } } } while (0)
struct XcdBarrier { unsigned* bar; unsigned x; volatile LAS unsigned* st; };
__device__ __forceinline__ XcdBarrier xcd_barrier_post(unsigned* bar, volatile LAS unsigned* st) {
    XcdBarrier b; b.bar = bar; b.x = xb_xcc_id(); b.st = st;
    if (threadIdx.x == 0) (void)xb_add(&bar[XB_XCNT(b.x)], 1u);
    return b;
}
__device__ __forceinline__ void xcd_barrier_complete(unsigned* bar, unsigned x, unsigned& nloc, unsigned& nx) {
    const unsigned G = gridDim.x * gridDim.y * gridDim.z;
    unsigned sum, cnt, mine, sp = 0u;
    for (;;) {
        sum = 0u; cnt = 0u; mine = 0u;
#pragma unroll
        for (unsigned j = 0; j < 16; ++j) { const unsigned c = xb_ld(&bar[XB_XCNT(j)]); sum += c; cnt += (c > 0u) ? 1u : 0u; mine = (j == x) ? c : mine; }
        if (sum == G) break;
        __builtin_amdgcn_s_sleep(1);
        if ((++sp & 255u) == 0u) { if (xb_ld(&bar[XB_TMO])) break; if (sp > XB_SPIN_CAP) { atomicAdd(&bar[XB_TMO], 1u); break; } }
    }
    nloc = mine > 0u ? mine : 1u; nx = cnt > 0u ? cnt : 1u;
}
__device__ __forceinline__ void xcd_barrier_arrive(const XcdBarrier& b) {
    asm volatile("s_waitcnt vmcnt(0)" ::: "memory");
    __syncthreads();
    if (threadIdx.x == 0) {
        unsigned* bar = b.bar;
        __builtin_amdgcn_s_waitcnt(0);
        unsigned nloc = b.st[0], nx = b.st[1];
        if (nloc == 0u) { xcd_barrier_complete(bar, b.x, nloc, nx); b.st[0] = nloc; b.st[1] = nx; }
        const unsigned old = xb_add(&bar[XB_XSUB(b.x)], 1u);
        const unsigned gen = old / nloc;
        if (old + 1u == (gen + 1u) * nloc) {
            __builtin_amdgcn_fence(__ATOMIC_RELEASE, "agent");
            asm volatile("s_waitcnt vmcnt(0)" ::: "memory");
            const unsigned og = xb_add(&bar[XB_TOP], 1u);
            const unsigned tg = og / nx;
            if (og + 1u == (tg + 1u) * nx) {
#pragma unroll
                for (int j = 0; j < 16; ++j) (void)__hip_atomic_fetch_add(&bar[XB_XGEN(j)], 1u, __ATOMIC_RELAXED, __HIP_MEMORY_SCOPE_AGENT);
            }
        }
    }
}
__device__ __forceinline__ void xcd_barrier_wait(const XcdBarrier& b, unsigned k) {
    if (threadIdx.x == 0) {
        unsigned* bar = b.bar;
        XB_SPIN((int)(xb_ld(&bar[XB_XGEN(b.x)]) - k) < 0, bar);
        __builtin_amdgcn_fence(__ATOMIC_ACQUIRE, "agent");
        asm volatile("s_waitcnt vmcnt(0)" ::: "memory");
    }
    __syncthreads();
}
__device__ __forceinline__ void xcd_barrier(const XcdBarrier& b, unsigned k) { xcd_barrier_arrive(b); xcd_barrier_wait(b, k); }

namespace pg8 {
#define PG8_LAS __attribute__((address_space(3)))
constexpr int BM = 256, BK = 64, HALF = 128, HTB = HALF * BK * 2, STAGE_BYTES = 8 * HTB, NXCD = 8, WGM = 8;
__host__ __device__ __forceinline__ int lds_byte(int r, int c) { const int st = (r >> 4) * 2 + (c >> 5), rr = r & 15, cc = c & 31, ob = rr * 64 + cc * 2; return st * 1024 + (ob ^ (((ob >> 9) & 1) << 5)); }
__host__ __device__ __forceinline__ void stage_rc(int b, int& R, int& C) { const int st = b / 1024, sb = b % 1024, swz = sb ^ (((sb >> 9) & 1) << 5); R = (st >> 1) * 16 + swz / 64; C = (st & 1) * 32 + (swz % 64) / 2; }
__host__ __device__ __forceinline__ int perm32(int rho) { const int n = rho >> 4, i = rho & 15; return 8 * (i >> 2) + 4 * n + (i & 3); }
struct Unit { int pm, pn; };
struct Gemm { const bf16_t* A; const bf16_t* Bt; int M, N, K; };
struct StaticOrder {
    int nM, nN, nwg, G, c, nlim;
    __host__ __device__ void init(int M, int N, int G_, int c_) { nM = M / BM; nN = N / BM; nwg = nM * nN; G = G_; c = c_; nlim = nwg; }
    __host__ __device__ bool at(long L, Unit& u) const {
        int wgid = (int)L; { const int q = nwg / NXCD, r = nwg % NXCD, xcd = wgid % NXCD, off = wgid / NXCD; wgid = (xcd < r ? xcd * (q + 1) : r * (q + 1) + (xcd - r) * q) + off; }
        const int nig = WGM * nN, gid = wgid / nig, fm = gid * WGM, gsz = (nM - fm) < WGM ? (nM - fm) : WGM;
        u.pm = fm + ((wgid % nig) % gsz); u.pn = (wgid % nig) / gsz; return true;
    }
    __host__ __device__ bool next(int i, Unit& u) const { const long L = (long)i * G + c; if (L >= nlim) return false; return at(L, u); }
    __device__ __forceinline__ void a_ready(const Unit&) const {}
    __device__ __forceinline__ void done(const Unit&) const {}
};
struct EpiZ {
    static constexpr bool PERM = true, AFTER_DRAIN = false;
    bf16_t* O; int ldc; const float* bias; int pn_off;
    template <int NAI> __device__ __forceinline__ void run(const f32x4 (&acc)[NAI][2][4][2], int rowbase, int pn_, int wr, int wc, int fr, int fq) const {
        const int row0 = rowbase + wr * 64 + fr; const int pn = pn_ + pn_off;
        const bool glu = (pn >= 8 && pn < 16);
        const int cin = wc * 32 + 8 * fq;
        const int bc0 = glu ? ZC_U1 + 128 * (pn - 8) + cin : pn * BM + cin;
        const int bc1 = glu ? ZC_U2 + 128 * (pn - 8) + cin : pn * BM + HALF + cin;
        f32x4 bv[2][2];
#pragma unroll
        for (int n = 0; n < 2; ++n) { bv[0][n] = *(const f32x4*)(bias + bc0 + 4 * n); bv[1][n] = *(const f32x4*)(bias + bc1 + 4 * n); }
        if (glu) {
#pragma unroll
            for (int ai = 0; ai < NAI; ++ai)
#pragma unroll
                for (int m = 0; m < 4; ++m) { bf16_t* rowp = O + (size_t)(row0 + ai * HALF + m * 16) * ldc + bc0;
                    const f32x4 a0 = acc[ai][0][m][0] + bv[0][0], a1 = acc[ai][0][m][1] + bv[0][1], g0 = acc[ai][1][m][0] + bv[1][0], g1 = acc[ai][1][m][1] + bv[1][1];
                    u32x4 w; w.x = cvt_pk_bf16(a0[0] * sigm(g0[0]), a0[1] * sigm(g0[1])); w.y = cvt_pk_bf16(a0[2] * sigm(g0[2]), a0[3] * sigm(g0[3]));
                    w.z = cvt_pk_bf16(a1[0] * sigm(g1[0]), a1[1] * sigm(g1[1])); w.w = cvt_pk_bf16(a1[2] * sigm(g1[2]), a1[3] * sigm(g1[3]));
                    *(u32x4*)rowp = w; }
        } else {
#pragma unroll
            for (int ai = 0; ai < NAI; ++ai)
#pragma unroll
                for (int m = 0; m < 4; ++m) { bf16_t* rowp = O + (size_t)(row0 + ai * HALF + m * 16) * ldc + bc0;
#pragma unroll
                    for (int bj = 0; bj < 2; ++bj) { const f32x4 v0 = acc[ai][bj][m][0] + bv[bj][0], v1 = acc[ai][bj][m][1] + bv[bj][1];
                        u32x4 w; w.x = cvt_pk_bf16(v0[0], v0[1]); w.y = cvt_pk_bf16(v0[2], v0[3]); w.z = cvt_pk_bf16(v1[0], v1[1]); w.w = cvt_pk_bf16(v1[2], v1[3]);
                        *(u32x4*)(rowp + bj * HALF) = w; } }
        }
    }
};
struct EpiPW {
    static constexpr bool PERM = true, AFTER_DRAIN = false;
    bf16_t* Y; const bf16_t* Z; const float* bias;
    template <int NAI> __device__ __forceinline__ void run(const f32x4 (&acc)[NAI][2][4][2], int rowbase, int pn, int wr, int wc, int fr, int fq) const {
        const int row0 = rowbase + wr * 64 + fr; const int col0 = pn * BM + wc * 32 + 8 * fq;
        f32x4 bv[2][2];
#pragma unroll
        for (int bj = 0; bj < 2; ++bj)
#pragma unroll
            for (int n = 0; n < 2; ++n) bv[bj][n] = *(const f32x4*)(bias + col0 + bj * HALF + 4 * n);
#pragma unroll
        for (int ai = 0; ai < NAI; ++ai)
#pragma unroll
            for (int m = 0; m < 4; ++m) { const size_t row = (size_t)(row0 + ai * HALF + m * 16);
#pragma unroll
                for (int bj = 0; bj < 2; ++bj) { const f32x4 v0 = acc[ai][bj][m][0] + bv[bj][0], v1 = acc[ai][bj][m][1] + bv[bj][1];
                    const u32x4 g = *(const u32x4*)(Z + row * NIN + ZC_GC + col0 + bj * HALF);
                    u32x4 w;
                    w.x = cvt_pk_bf16(v0[0] * siluf(bf_lo(g.x)), v0[1] * siluf(bf_hi(g.x)));
                    w.y = cvt_pk_bf16(v0[2] * siluf(bf_lo(g.y)), v0[3] * siluf(bf_hi(g.y)));
                    w.z = cvt_pk_bf16(v1[0] * siluf(bf_lo(g.z)), v1[1] * siluf(bf_hi(g.z)));
                    w.w = cvt_pk_bf16(v1[2] * siluf(bf_lo(g.w)), v1[3] * siluf(bf_hi(g.w)));
                    *(u32x4*)(Y + row * DM + DL + col0 + bj * HALF) = w; } }
    }
};
struct EpiOut {
    static constexpr bool PERM = false, AFTER_DRAIN = true;
    const float* x; float* out; const float* pw; float* part; unsigned* cnt;
    __device__ __forceinline__ void fused(f32x4 (&acc)[2][2][4][2], const Unit& u, int wr, int wc, int fr, int fq, PG8_LAS unsigned char* lds, int wid, int lane) const {
        PG8_LAS float* P = (PG8_LAS float*)lds;
        PG8_LAS float* S = (PG8_LAS float*)(lds + 8192);
#pragma unroll
        for (int ai = 0; ai < 2; ++ai)
#pragma unroll
            for (int m = 0; m < 4; ++m) { float s = 0.f;
#pragma unroll
                for (int bj = 0; bj < 2; ++bj)
#pragma unroll
                    for (int n = 0; n < 2; ++n) { const f32x4 v = acc[ai][bj][m][n]; s += (v[0] * v[0] + v[1] * v[1]) + (v[2] * v[2] + v[3] * v[3]); }
                s += __shfl_xor(s, 16); s += __shfl_xor(s, 32);
                if (fq == 0) P[(ai * HALF + wr * 64 + m * 16 + fr) * 4 + wc] = s; }
        __syncthreads();
        const int tid = wid * 64 + lane;
        if (tid < 256) { const float t = (P[tid * 4 + 0] + P[tid * 4 + 1]) + (P[tid * 4 + 2] + P[tid * 4 + 3]); __hip_atomic_store(part + (size_t)(u.pm * BM + tid) * 8 + u.pn, t, __ATOMIC_RELAXED, __HIP_MEMORY_SCOPE_AGENT);
            asm volatile("s_waitcnt vmcnt(0)" ::: "memory");
            if (lane == 0) __hip_atomic_fetch_add(cnt + 64 * u.pm, 1u, __ATOMIC_RELAXED, __HIP_MEMORY_SCOPE_AGENT); }
        PG8_LAS float* T = (PG8_LAS float*)(lds + 9216);
        constexpr int TS = 260;
        const size_t gbase = (size_t)(u.pm * BM) * DM + (size_t)u.pn * BM + 4 * lane;
        f32x4 xr[16];
#pragma unroll
        for (int rr = 0; rr < 16; ++rr) xr[rr] = __builtin_nontemporal_load((const f32x4*)(x + gbase + (size_t)(wid * 16 + rr) * DM));
        if (wid == 0) {
            unsigned sp = 0;
            while ((unsigned)__builtin_amdgcn_readfirstlane(__hip_atomic_load(cnt + 64 * u.pm, __ATOMIC_RELAXED, __HIP_MEMORY_SCOPE_AGENT)) < 32u) { __builtin_amdgcn_s_sleep(2); if (++sp > (1u << 22)) break; }
            __builtin_amdgcn_fence(__ATOMIC_ACQUIRE, "agent");
            asm volatile("s_waitcnt vmcnt(0)" ::: "memory");
        }
        __syncthreads();
        if (tid < 256) { const float* pp = part + (size_t)(u.pm * BM + tid) * 8; float t = 0.f;
#pragma unroll
            for (int k = 0; k < 8; ++k) t += __hip_atomic_load(pp + k, __ATOMIC_RELAXED, __HIP_MEMORY_SCOPE_AGENT);
            S[tid] = 1.0f / sqrtf(t * (1.0f / (float)DM) + EPS); }
        const f32x4 wv = *(const f32x4*)(pw + u.pn * BM + 4 * lane);
        f32x4 xr2[16];
#pragma unroll
        for (int ai = 0; ai < 2; ++ai) {
            if (ai == 1) __syncthreads();
#pragma unroll
            for (int m = 0; m < 4; ++m)
#pragma unroll
                for (int bj = 0; bj < 2; ++bj)
#pragma unroll
                    for (int n = 0; n < 2; ++n) *(PG8_LAS f32x4*)(T + (wr * 64 + m * 16 + fr) * TS + bj * HALF + wc * 32 + n * 16 + 4 * fq) = acc[ai][bj][m][n];
            if (ai == 0) {
#pragma unroll
                for (int rr = 0; rr < 16; ++rr) xr2[rr] = __builtin_nontemporal_load((const f32x4*)(x + gbase + (size_t)(HALF + wid * 16 + rr) * DM));
            }
            __syncthreads();
#pragma unroll
            for (int rr = 0; rr < 16; ++rr) { const int rl = wid * 16 + rr; const float rs = S[ai * HALF + rl];
                const f32x4 y = *(const PG8_LAS f32x4*)(T + rl * TS + 4 * lane);
                const f32x4 o = (ai == 0 ? xr[rr] : xr2[rr]) + y * rs * wv;
                __builtin_nontemporal_store(o, (f32x4*)(out + gbase + (size_t)(ai * HALF + rl) * DM)); }
        }
    }
};

template <class Epi, class Sched, bool ALIGN_EPI = false>
__device__ __forceinline__ void gemm_phase(PG8_LAS unsigned char* lds, const Gemm g, const Sched& S, const Epi& E) {
    int tid = threadIdx.x; asm volatile("" : "+v"(tid));
    const int wid = __builtin_amdgcn_readfirstlane(tid >> 6), lane = tid & 63, wr = wid >> 2, wc = wid & 3, fr = lane & 15, fq = lane >> 4;
    const int K = g.K, nt = K / BK;
    unsigned voffA[2], voffB[2];
#pragma unroll
    for (int i = 0; i < 2; ++i) { int R, C; stage_rc(tid * 16 + i * 8192, R, C); const int Rb = Epi::PERM ? ((R & ~31) + perm32(R & 31)) : R;
        voffA[i] = (unsigned)(R * K + C) * 2u; voffB[i] = (unsigned)(Rb * K + C) * 2u; }
    const size_t kstep = (size_t)(BK * 2);
    const size_t hstep = (size_t)HALF * K * 2;
    const size_t tstep = 2 * hstep;
    const unsigned ldsw = (unsigned)wid * 1024u;
    const int aoff = lds_byte(wr * 64 + fr, fq * 8), boff = lds_byte(wc * 32 + fr, fq * 8);
#define PG8_SA(b, h) (((b) * 2 + (h)) * HTB)
#define PG8_SB(b, h) ((4 + (b) * 2 + (h)) * HTB)
#define PG8_STAGE(bufoff, gbase, voff) do { _Pragma("unroll") for (int _i = 0; _i < 2; ++_i) \
        __builtin_amdgcn_global_load_lds((const unsigned*)((const char*)(gbase) + (voff)[_i]), (PG8_LAS unsigned*)(lds + (bufoff) + ldsw + _i * 8192), 16, 0, 0); } while (0)
#define PG8_LDA(dst, b, h) do { _Pragma("unroll") for (int m = 0; m < 4; ++m) _Pragma("unroll") for (int k = 0; k < 2; ++k) dst[m][k] = *(const PG8_LAS bf16x8*)(lds + PG8_SA(b, h) + aoff + m * 2048 + k * 1024); } while (0)
#define PG8_LDB(dst, b, h) do { _Pragma("unroll") for (int n = 0; n < 2; ++n) _Pragma("unroll") for (int k = 0; k < 2; ++k) dst[n][k] = *(const PG8_LAS bf16x8*)(lds + PG8_SB(b, h) + boff + n * 2048 + k * 1024); } while (0)
#define PG8_MMA(ai, bj, At, Bt) do { __builtin_amdgcn_s_setprio(1); _Pragma("unroll") for (int m = 0; m < 4; ++m) _Pragma("unroll") for (int n = 0; n < 2; ++n) _Pragma("unroll") for (int k = 0; k < 2; ++k) \
        acc[ai][bj][m][n] = __builtin_amdgcn_mfma_f32_16x16x32_bf16(Bt[n][k], At[m][k], acc[ai][bj][m][n], 0, 0, 0); __builtin_amdgcn_s_setprio(0); } while (0)
#define PG8_WAIT_V(n) asm volatile("s_waitcnt vmcnt(" #n ")" ::: "memory")
#define PG8_WAIT_L(n) asm volatile("s_waitcnt lgkmcnt(" #n ")" ::: "memory")
#define PG8_BAR __builtin_amdgcn_s_barrier()
#define PG8_SCHED __builtin_amdgcn_sched_barrier(0)
    Unit cur, nxt; int ui = 0;
    if (!S.next(0, cur)) return;
    f32x4 acc[2][2][4][2];
#pragma unroll
    for (int a = 0; a < 2; ++a)
#pragma unroll
        for (int b = 0; b < 2; ++b)
#pragma unroll
            for (int m = 0; m < 4; ++m)
#pragma unroll
                for (int n = 0; n < 2; ++n) acc[a][b][m][n] = (f32x4){0.f, 0.f, 0.f, 0.f};
    bf16x8 At[4][2], B0[2][2], B1[2][2];
    const char* cA = (const char*)g.A + (size_t)cur.pm * tstep; const char* cB = (const char*)g.Bt + (size_t)cur.pn * tstep;
    S.a_ready(cur);
    PG8_STAGE(PG8_SB(0, 0), cB, voffB); PG8_STAGE(PG8_SB(0, 1), cB + hstep, voffB); PG8_STAGE(PG8_SA(0, 0), cA, voffA); PG8_STAGE(PG8_SA(0, 1), cA + hstep, voffA);
    if (wr == 1) PG8_BAR;
    PG8_WAIT_V(2); PG8_BAR;
    PG8_STAGE(PG8_SB(1, 0), cB + kstep, voffB); PG8_STAGE(PG8_SA(1, 0), cA + kstep, voffA); PG8_STAGE(PG8_SB(1, 1), cB + hstep + kstep, voffB);
    PG8_WAIT_V(6); PG8_BAR;
    for (;;) {
        const bool has_next = S.next(ui + 1, nxt);
        const char* nA = has_next ? (const char*)g.A + (size_t)nxt.pm * tstep : cA; const char* nB = has_next ? (const char*)g.Bt + (size_t)nxt.pn * tstep : cB;
        for (int t = 0; t < nt; t += 2) {
            const bool last = (t == nt - 2);
            const char* a1 = cA + (size_t)(t + 1) * kstep;
            const char* a2 = last ? nA : cA + (size_t)(t + 2) * kstep; const char* b2 = last ? nB : cB + (size_t)(t + 2) * kstep;
            const char* a3 = a2 + kstep; const char* b3 = b2 + kstep;
            if (last && has_next) S.a_ready(nxt);
            PG8_LDB(B0, 0, 0); PG8_LDB(B1, 0, 1); PG8_SCHED; PG8_LDA(At, 0, 0); PG8_STAGE(PG8_SA(1, 1), a1 + hstep, voffA);
            PG8_WAIT_V(8); PG8_WAIT_L(0); PG8_BAR; PG8_MMA(0, 0, At, B0); PG8_MMA(0, 1, At, B1); PG8_BAR; PG8_SCHED;
            PG8_LDA(At, 0, 1); PG8_STAGE(PG8_SB(0, 0), b2, voffB); PG8_STAGE(PG8_SB(0, 1), b2 + hstep, voffB); PG8_STAGE(PG8_SA(0, 0), a2, voffA);
            PG8_WAIT_V(8); PG8_WAIT_L(0); PG8_BAR; PG8_MMA(1, 0, At, B0); PG8_MMA(1, 1, At, B1); PG8_BAR; PG8_SCHED;
            PG8_LDB(B0, 1, 0); PG8_LDB(B1, 1, 1); PG8_SCHED; PG8_LDA(At, 1, 0); PG8_STAGE(PG8_SA(0, 1), a2 + hstep, voffA);
            PG8_WAIT_V(8); PG8_WAIT_L(0); PG8_BAR; PG8_MMA(0, 0, At, B0); PG8_MMA(0, 1, At, B1); PG8_BAR; PG8_SCHED;
            PG8_LDA(At, 1, 1); PG8_STAGE(PG8_SB(1, 0), b3, voffB); PG8_STAGE(PG8_SB(1, 1), b3 + hstep, voffB); PG8_STAGE(PG8_SA(1, 0), a3, voffA);
            PG8_WAIT_V(8); PG8_WAIT_L(0); PG8_BAR; PG8_MMA(1, 0, At, B0); PG8_MMA(1, 1, At, B1); PG8_BAR; PG8_SCHED;
        }
        if constexpr (ALIGN_EPI) { if (wr == 0) PG8_BAR; }
        if constexpr (!Epi::AFTER_DRAIN) { E.template run<2>(acc, cur.pm * BM, cur.pn, wr, wc, fr, fq); S.done(cur); }
        if (!has_next) break;
#pragma unroll
        for (int a = 0; a < 2; ++a)
#pragma unroll
            for (int b = 0; b < 2; ++b)
#pragma unroll
                for (int m = 0; m < 4; ++m)
#pragma unroll
                    for (int n = 0; n < 2; ++n) acc[a][b][m][n] = (f32x4){0.f, 0.f, 0.f, 0.f};
        cur = nxt; cA = nA; cB = nB; ++ui;
        if constexpr (ALIGN_EPI) { if (wr == 1) PG8_BAR; }
    }
    PG8_WAIT_V(0);
    if constexpr (!ALIGN_EPI) { if (wr == 0) PG8_BAR; }
    PG8_BAR;
    if constexpr (Epi::AFTER_DRAIN) { E.fused(acc, cur, wr, wc, fr, fq, lds, wid, lane); S.done(cur); }
#undef PG8_SA
#undef PG8_SB
#undef PG8_STAGE
#undef PG8_LDA
#undef PG8_LDB
#undef PG8_MMA
#undef PG8_WAIT_V
#undef PG8_WAIT_L
#undef PG8_BAR
#undef PG8_SCHED
}

template <class Epi>
__device__ __forceinline__ void gemm_half_phase(PG8_LAS unsigned char* lds, const bf16_t* Ah, const bf16_t* Bh, int K, int rowbase, int pn, const Epi& E) {
    int tid = threadIdx.x; asm volatile("" : "+v"(tid));
    const int wid = __builtin_amdgcn_readfirstlane(tid >> 6), lane = tid & 63, wr = wid >> 2, wc = wid & 3, fr = lane & 15, fq = lane >> 4;
    const int nt = K / BK;
    unsigned voffA[2], voffB[2];
#pragma unroll
    for (int i = 0; i < 2; ++i) { int R, C; stage_rc(tid * 16 + i * 8192, R, C); const int Rb = Epi::PERM ? ((R & ~31) + perm32(R & 31)) : R;
        voffA[i] = (unsigned)(R * K + C) * 2u; voffB[i] = (unsigned)(Rb * K + C) * 2u; }
    const size_t kstep = (size_t)(BK * 2);
    const size_t hstep = (size_t)HALF * K * 2;
    const unsigned ldsw = (unsigned)wid * 1024u;
    const int aoff = lds_byte(wr * 64 + fr, fq * 8), boff = lds_byte(wc * 32 + fr, fq * 8);
    constexpr int SST = 3 * HTB;
#define PH_STAGE(bufoff, gbase, voff) do { _Pragma("unroll") for (int _i = 0; _i < 2; ++_i) \
        __builtin_amdgcn_global_load_lds((const unsigned*)((const char*)(gbase) + (voff)[_i]), (PG8_LAS unsigned*)(lds + (bufoff) + ldsw + _i * 8192), 16, 0, 0); } while (0)
#define PH_STAGE_TILE(so, tt) do { PH_STAGE((so) + HTB, cB + (size_t)(tt) * kstep, voffB); PH_STAGE((so) + 2 * HTB, cB + hstep + (size_t)(tt) * kstep, voffB); PH_STAGE((so), cA + (size_t)(tt) * kstep, voffA); } while (0)
#define PH_LDA(dst, so) do { _Pragma("unroll") for (int m = 0; m < 4; ++m) _Pragma("unroll") for (int k = 0; k < 2; ++k) dst[m][k] = *(const PG8_LAS bf16x8*)(lds + (so) + aoff + m * 2048 + k * 1024); } while (0)
#define PH_LDB(dst, so, h) do { _Pragma("unroll") for (int n = 0; n < 2; ++n) _Pragma("unroll") for (int k = 0; k < 2; ++k) dst[n][k] = *(const PG8_LAS bf16x8*)(lds + (so) + HTB + (h) * HTB + boff + n * 2048 + k * 1024); } while (0)
#define PH_MMA(bj, At, Bt) do { __builtin_amdgcn_s_setprio(1); _Pragma("unroll") for (int m = 0; m < 4; ++m) _Pragma("unroll") for (int n = 0; n < 2; ++n) _Pragma("unroll") for (int k = 0; k < 2; ++k) \
        acc[0][bj][m][n] = __builtin_amdgcn_mfma_f32_16x16x32_bf16(Bt[n][k], At[m][k], acc[0][bj][m][n], 0, 0, 0); __builtin_amdgcn_s_setprio(0); } while (0)
#define PH_WAIT_V(n) asm volatile("s_waitcnt vmcnt(" #n ")" ::: "memory")
#define PH_WAIT_L(n) asm volatile("s_waitcnt lgkmcnt(" #n ")" ::: "memory")
#define PH_BAR __builtin_amdgcn_s_barrier()
#define PH_SCHED __builtin_amdgcn_sched_barrier(0)
    f32x4 acc[1][2][4][2];
#pragma unroll
    for (int b = 0; b < 2; ++b)
#pragma unroll
        for (int m = 0; m < 4; ++m)
#pragma unroll
            for (int n = 0; n < 2; ++n) acc[0][b][m][n] = (f32x4){0.f, 0.f, 0.f, 0.f};
    bf16x8 At[4][2], B0[2][2], B1[2][2];
    const char* cA = (const char*)Ah; const char* cB = (const char*)Bh;
    PH_STAGE_TILE(0, 0); PH_STAGE_TILE(SST, 1);
    if (wr == 1) PH_BAR;
    PH_WAIT_V(6); PH_BAR;
    PH_BAR;
    int so = 0, so2 = 2 * SST;
    for (int t = 0; t < nt; ++t) {
        const int t2 = (t + 2 < nt) ? t + 2 : t + 2 - nt;
        PH_LDB(B0, so, 0); PH_LDB(B1, so, 1); PH_SCHED; PH_LDA(At, so); PH_STAGE_TILE(so2, t2);
        PH_WAIT_V(6); PH_WAIT_L(0); PH_BAR; PH_MMA(0, At, B0); PH_MMA(1, At, B1); PH_BAR; PH_SCHED;
        so = (so == 2 * SST) ? 0 : so + SST; so2 = (so2 == 2 * SST) ? 0 : so2 + SST;
    }
    E.template run<1>(acc, rowbase, pn, wr, wc, fr, fq);
    PH_WAIT_V(0);
    if (wr == 0) PH_BAR;
    PH_BAR;
#undef PH_STAGE
#undef PH_STAGE_TILE
#undef PH_LDA
#undef PH_LDB
#undef PH_MMA
#undef PH_WAIT_V
#undef PH_WAIT_L
#undef PH_BAR
#undef PH_SCHED
}
}

__device__ __forceinline__ float wave_sum(float v) {
#pragma unroll
    for (int o = 1; o < 64; o <<= 1) v += __shfl_xor(v, o);
    return v;
}
template <bool GLU_PERM>
__device__ __forceinline__ void p0_transpose_item(const float* W, int K, int N, bf16_t* WT, LAS float* scr, int item, int lane) {
    const int nblk = N / 32, kb = item / nblk, nb = item % nblk, k0 = 64 * kb, n0 = 32 * nb;
    int d0 = n0;
    if (GLU_PERM) { if (n0 >= ZC_U1 && n0 < ZC_U2) { const int ch = n0 - ZC_U1; d0 = ZC_U1 + 256 * (ch >> 7) + (ch & 127); } else if (n0 >= ZC_U2 && n0 < ZC_GC) { const int ch = n0 - ZC_U2; d0 = ZC_U1 + 256 * (ch >> 7) + 128 + (ch & 127); } }
    float tv[32];
#pragma unroll
    for (int i = 0; i < 32; ++i) { const int kk = 2 * i + (lane >> 5); tv[i] = __builtin_nontemporal_load(W + (size_t)(k0 + kk) * N + n0 + (lane & 31)); }
#pragma unroll
    for (int i = 0; i < 32; ++i) { const int kk = 2 * i + (lane >> 5); scr[kk * 33 + (lane & 31)] = tv[i]; }
    asm volatile("s_waitcnt lgkmcnt(0)" ::: "memory");
    const int c = lane & 7;
#pragma unroll
    for (int j = 0; j < 4; ++j) { const int n = (lane >> 3) + 8 * j; const LAS float* s = scr + (8 * c) * 33 + n;
        u32x4 o; o.x = cvt_pk_bf16(s[0 * 33], s[1 * 33]); o.y = cvt_pk_bf16(s[2 * 33], s[3 * 33]); o.z = cvt_pk_bf16(s[4 * 33], s[5 * 33]); o.w = cvt_pk_bf16(s[6 * 33], s[7 * 33]);
        *(u32x4*)(WT + (size_t)(d0 + n) * K + k0 + 8 * c) = o; }
    asm volatile("s_waitcnt lgkmcnt(0)" ::: "memory");
}

struct Args {
    const float *x, *meta, *pre_w, *post_w, *w_in, *b_in, *lcw, *lcb, *wga, *bga, *wgx, *bgx, *lam, *cdw, *cdb, *clw, *clb, *cpw, *cpb, *w_out;
    float* out; unsigned char* ws;
};

__device__ __forceinline__ const bf16_t* zrow(const bf16_t* Z, int b, int hidx) { const int row = hidx < NMETA ? MX + hidx : b * SEQ + hidx - NMETA; return Z + (size_t)row * NIN; }

template <int N> struct RS {
    template <int MASK> static __device__ __forceinline__ void step(float (&v)[64], int lane) {
#pragma unroll
        for (int j = 0; j < N; ++j) { const float lo = v[j], hi = v[j + N]; const bool up = (lane & MASK) != 0; const float send = up ? lo : hi, keep = up ? hi : lo; v[j] = keep + __shfl_xor(send, MASK); }
    }
};

template <int RR> __device__ __forceinline__ void conv_row(f32x2 (&ac)[32], const f32x2 (&wk)[31], const LAS unsigned char* p) {
    const unsigned v = *(const LAS unsigned*)(p + RR * 2048); const f32x2 v2 = (f32x2){bf_lo(v), bf_hi(v)};
    constexpr int lo = RR - 30 > 0 ? RR - 30 : 0, hi = RR < 31 ? RR : 31;
#pragma unroll
    for (int o = lo; o <= hi; ++o) ac[o] = __builtin_elementwise_fma(wk[RR - o], v2, ac[o]);
}
template <int... R> __device__ __forceinline__ void conv_all(f32x2 (&ac)[32], const f32x2 (&wk)[31], const LAS unsigned char* p, std::integer_sequence<int, R...>) { (conv_row<R>(ac, wk, p), ...); }

__device__ __forceinline__ void conf_tile(const Args& A, const bf16_t* Z, bf16_t* VLN, LAS unsigned char* lds, int ti) {
    int tid = threadIdx.x; asm volatile("" : "+v"(tid));
    const int lane = tid & 63, wid = tid >> 6;
    const int b = ti >> 6, t0 = (ti & 63) * 32, i0 = NMETA + t0;
    LAS float* red = (LAS float*)(lds + 126976);
    LAS float* stats = (LAS float*)(lds + 129024);
    f32x2 wk[31];
    { const char* wp = (const char*)(A.cdw + 2 * tid);
#pragma unroll
      for (int k = 0; k < 31; ++k) { wk[k] = *(const f32x2*)wp; wp += DC * 4; asm volatile("" : "+v"(wp)); } }
    { u32x4 tv[16];
#pragma unroll
      for (int it = 0; it < 16; ++it) { const int idx = tid + 512 * it; const int rr = idx >> 7, c8 = idx & 127; const int hidx = i0 - 30 + rr;
          tv[it] = (u32x4){0u, 0u, 0u, 0u};
          if (idx < 62 * 128 && hidx >= 0) tv[it] = *(const u32x4*)(zrow(Z, b, hidx) + ZC_U1 + 8 * c8); }
#pragma unroll
      for (int it = 0; it < 16; ++it) { const int idx = tid + 512 * it; const int rr = idx >> 7, c8 = idx & 127;
          if (idx < 62 * 128) *(LAS u32x4*)(lds + rr * 2048 + c8 * 16) = tv[it]; } }
    __syncthreads();
    f32x2 ac[32];
    { const f32x2 bb = *(const f32x2*)(A.cdb + 2 * tid);
#pragma unroll
      for (int o = 0; o < 32; ++o) ac[o] = bb; }
    conv_all(ac, wk, lds + tid * 4, std::make_integer_sequence<int, 62>{});
    float v[64];
#pragma unroll
    for (int o = 0; o < 32; ++o) { v[2 * o] = ac[o].x + ac[o].y; v[2 * o + 1] = ac[o].x * ac[o].x + ac[o].y * ac[o].y; }
    RS<32>::step<32>(v, lane); RS<16>::step<16>(v, lane); RS<8>::step<8>(v, lane); RS<4>::step<4>(v, lane); RS<2>::step<2>(v, lane); RS<1>::step<1>(v, lane);
    red[wid * 64 + lane] = v[0];
    __syncthreads();
    if (tid < 64) { float s = 0.f;
#pragma unroll
        for (int w = 0; w < 8; ++w) s += red[w * 64 + tid];
        red[tid] = s; }
    __syncthreads();
    if (tid < 32) { const float s1 = red[2 * tid], s2 = red[2 * tid + 1]; const float mean = s1 * (1.0f / DC); const float var = s2 * (1.0f / DC) - mean * mean;
        stats[2 * tid] = mean; stats[2 * tid + 1] = 1.0f / sqrtf(fmaxf(var, 0.f) + EPS); }
    __syncthreads();
    const f32x2 lw = *(const f32x2*)(A.clw + 2 * tid), lb = *(const f32x2*)(A.clb + 2 * tid);
    unsigned* op = (unsigned*)(VLN + (size_t)(b * SEQ + t0) * DC + 2 * tid);
#pragma unroll
    for (int o = 0; o < 32; ++o) { const float mean = stats[2 * o], rstd = stats[2 * o + 1];
        const float y0 = (ac[o].x - mean) * rstd * lw.x + lb.x, y1 = (ac[o].y - mean) * rstd * lw.y + lb.y;
        op[(size_t)o * (DC / 2)] = cvt_pk_bf16(siluf(y0), siluf(y1)); }
    __syncthreads();
}

constexpr int L_WL = 0, L_CW = 16384, L_CST = 17664, L_XT = 18688, XT_STRIDE = 144, XT_BYTES = 16 * XT_STRIDE, L_WT = L_XT + 8 * XT_BYTES;
static_assert(L_WT == 37120, "lds map");
constexpr int L_XS = L_WT + 4096, XS_STRIDE = 144, XS_ROWS = 515, L_YT = L_XS, YT_STRIDE = 144, YT_BYTES = 64 * YT_STRIDE;
static_assert(L_XS + XS_ROWS * XS_STRIDE <= 131072 && L_YT + 8 * YT_BYTES <= 131072 && 61 * XS_STRIDE >= 8448, "lds map");

template <bool STASH, bool FROM_LDS>
__device__ __forceinline__ void lru_mtile(const bf16_t* Z, int b, int h, int hb, const LAS unsigned char* xs, LAS unsigned char* lds, LAS unsigned char* xt, int lane,
                                          float (&cP)[4], float (&cH)[4], float (&sH)[4][4], float (&sP)[4][4]) {
    const int r = lane & 15, kq = lane >> 4;
    const LAS float* cw = (const LAS float*)(lds + L_CW);
    const LAS float* cst = (const LAS float*)(lds + L_CST);
    float xc[2][8];
#pragma unroll
    for (int ks = 0; ks < 2; ++ks) { const f32x4 b0 = *(const LAS f32x4*)(cw + 4 * 64 + 32 * ks + 8 * kq), b1 = *(const LAS f32x4*)(cw + 4 * 64 + 32 * ks + 8 * kq + 4);
        xc[ks][0] = b0[0]; xc[ks][1] = b0[1]; xc[ks][2] = b0[2]; xc[ks][3] = b0[3]; xc[ks][4] = b1[0]; xc[ks][5] = b1[1]; xc[ks][6] = b1[2]; xc[ks][7] = b1[3]; }
#pragma unroll
    for (int k = 0; k < 4; ++k) { const int hidx = hb + r - 3 + k;
        if (FROM_LDS || hidx >= 0) { const bf16_t* rp = zrow(Z, b, hidx < 0 ? 0 : hidx) + ZC_XL + 64 * h + 8 * kq;
#pragma unroll
            for (int ks = 0; ks < 2; ++ks) { u32x4 v;
                if (FROM_LDS) v = *(const LAS u32x4*)(xs + (r + k) * XS_STRIDE + (8 * kq + 32 * ks) * 2); else v = *(const u32x4*)(rp + 32 * ks);
                const f32x4 w0 = *(const LAS f32x4*)(cw + k * 64 + 32 * ks + 8 * kq), w1 = *(const LAS f32x4*)(cw + k * 64 + 32 * ks + 8 * kq + 4);
                xc[ks][0] += w0[0] * bf_lo(v.x); xc[ks][1] += w0[1] * bf_hi(v.x); xc[ks][2] += w0[2] * bf_lo(v.y); xc[ks][3] += w0[3] * bf_hi(v.y);
                xc[ks][4] += w1[0] * bf_lo(v.z); xc[ks][5] += w1[1] * bf_hi(v.z); xc[ks][6] += w1[2] * bf_lo(v.w); xc[ks][7] += w1[3] * bf_hi(v.w); } } }
    bf16x8 af[2];
#pragma unroll
    for (int ks = 0; ks < 2; ++ks) { u32x4 p; p.x = cvt_pk_bf16(xc[ks][0], xc[ks][1]); p.y = cvt_pk_bf16(xc[ks][2], xc[ks][3]); p.z = cvt_pk_bf16(xc[ks][4], xc[ks][5]); p.w = cvt_pk_bf16(xc[ks][6], xc[ks][7]);
        af[ks] = __builtin_bit_cast(bf16x8, p); *(LAS u32x4*)(xt + r * XT_STRIDE + (32 * ks + 8 * kq) * 2) = p; }
    asm volatile("s_waitcnt lgkmcnt(0)" ::: "memory");
    __builtin_amdgcn_wave_barrier();
#pragma unroll
    for (int ct = 0; ct < 4; ++ct) {
        const bf16x8 wa0 = *(const LAS bf16x8*)(lds + L_WL + ((0 * 4 + ct) * 2 + 0) * 1024 + lane * 16), wa1 = *(const LAS bf16x8*)(lds + L_WL + ((0 * 4 + ct) * 2 + 1) * 1024 + lane * 16);
        const bf16x8 wx0 = *(const LAS bf16x8*)(lds + L_WL + ((1 * 4 + ct) * 2 + 0) * 1024 + lane * 16), wx1 = *(const LAS bf16x8*)(lds + L_WL + ((1 * 4 + ct) * 2 + 1) * 1024 + lane * 16);
        f32x4 ra = (f32x4){0.f, 0.f, 0.f, 0.f}, ia = (f32x4){0.f, 0.f, 0.f, 0.f};
        ra = __builtin_amdgcn_mfma_f32_16x16x32_bf16(af[0], wa0, ra, 0, 0, 0); ra = __builtin_amdgcn_mfma_f32_16x16x32_bf16(af[1], wa1, ra, 0, 0, 0);
        ia = __builtin_amdgcn_mfma_f32_16x16x32_bf16(af[0], wx0, ia, 0, 0, 0); ia = __builtin_amdgcn_mfma_f32_16x16x32_bf16(af[1], wx1, ia, 0, 0, 0);
        const f32x4 c4 = *(const LAS f32x4*)(cst + (16 * ct + r) * 4);
        float p[4], hh[4];
#pragma unroll
        for (int j = 0; j < 4; ++j) {
            const float xcv = __uint_as_float((unsigned)(*(const LAS unsigned short*)(xt + (4 * kq + j) * XT_STRIDE + (16 * ct + r) * 2)) << 16);
            const float rr = __builtin_amdgcn_rcpf(1.0f + __builtin_amdgcn_exp2f(__builtin_fmaf(ra[j], -1.44269504f, c4[0])));
            const float ii = __builtin_amdgcn_rcpf(1.0f + __builtin_amdgcn_exp2f(__builtin_fmaf(ia[j], -1.44269504f, c4[1])));
            const float a = __builtin_amdgcn_exp2f(c4[2] * rr);
            const float x2 = c4[3] * rr;
            float om_p = -x2 * __builtin_fmaf(x2, 0.5f, 1.0f), om_b = __builtin_fmaf(-a, a, 1.0f); asm volatile("" : "+v"(om_p), "+v"(om_b));
            const float om = x2 > -2e-3f ? om_p : om_b;
            const float mult = __builtin_amdgcn_sqrtf(om); const float u = mult * ii * xcv;
            if (j == 0) { p[0] = a; hh[0] = u; } else { p[j] = p[j - 1] * a; hh[j] = hh[j - 1] * a + u; } }
        float EP = cP[ct], EH = cH[ct];
#pragma unroll
        for (int q = 0; q < 3; ++q) { float tp = __shfl(p[3], r + 16 * q), th = __shfl(hh[3], r + 16 * q); tp = q < kq ? tp : 1.0f; th = q < kq ? th : 0.0f; EH = EH * tp + th; EP = EP * tp; }
        if (STASH) {
#pragma unroll
            for (int j = 0; j < 4; ++j) { sH[ct][j] = EH * p[j] + hh[j]; sP[ct][j] = EP * p[j]; } }
        const float tP = EP * p[3], tH = EH * p[3] + hh[3];
        cP[ct] = __shfl(tP, r + 48); cH[ct] = __shfl(tH, r + 48);
        if (ct & 1) __builtin_amdgcn_sched_barrier(0);
    }
    __builtin_amdgcn_wave_barrier();
}

__device__ __forceinline__ void lru_fill_tables(const Args& A, int uh, LAS unsigned char* lds, int tid) {
    for (int f = tid; f < 1024; f += 512) { const int l = f & 63, ks = (f >> 6) & 1, ct = (f >> 7) & 3, gsel = f >> 9; const int n = l & 15, kq = l >> 4;
        const float* wsrc = (gsel ? A.wgx : A.wga) + (size_t)uh * 4096 + (size_t)(32 * ks + 8 * kq) * 64 + 16 * ct + n;
        u32x4 p; p.x = cvt_pk_bf16(wsrc[0], wsrc[64]); p.y = cvt_pk_bf16(wsrc[128], wsrc[192]); p.z = cvt_pk_bf16(wsrc[256], wsrc[320]); p.w = cvt_pk_bf16(wsrc[384], wsrc[448]);
        *(LAS u32x4*)(lds + L_WL + ((gsel * 4 + ct) * 2 + ks) * 1024 + l * 16) = p; }
    if (tid < 320) { const int k = tid >> 6, c = tid & 63; ((LAS float*)(lds + L_CW))[tid] = k < 4 ? A.lcw[k * DL + 64 * uh + c] : A.lcb[64 * uh + c]; }
    if (tid < 64) { const int c = 64 * uh + tid; const float lm = A.lam[c]; const float sp = (-lm > 20.f) ? -lm : log1pf(__expf(-lm));
        *(LAS f32x4*)(lds + L_CST + tid * 16) = (f32x4){-1.44269504f * A.bga[c], -1.44269504f * A.bgx[c], -8.0f * sp * 1.44269504f, -16.0f * sp}; }
}

__global__ void __launch_bounds__(512, 2) mega(Args A) {
    extern __shared__ __attribute__((aligned(16))) unsigned char lds_raw[];
    LAS unsigned char* lds = (LAS unsigned char*)lds_raw;
    unsigned* const bwords = (unsigned*)(A.ws + WS_CTL) + 1024;
    unsigned* const iflag = (unsigned*)(A.ws + WS_CTL); unsigned* const idone = iflag + 64; unsigned* const pcnt = iflag + 8192;
    if (threadIdx.x < 2) ((volatile LAS unsigned*)(lds + L_MISC))[threadIdx.x] = 0u;
    if (blockIdx.x == 0 && threadIdx.x < 64) {
        const int l = threadIdx.x;
        if (l < 16) { __hip_atomic_store(&bwords[XB_XCNT(l)], 0u, __ATOMIC_RELAXED, __HIP_MEMORY_SCOPE_AGENT); __hip_atomic_store(&bwords[XB_XSUB(l)], 0u, __ATOMIC_RELAXED, __HIP_MEMORY_SCOPE_AGENT);
                      __hip_atomic_store(&bwords[XB_XGEN(l)], 0u, __ATOMIC_RELAXED, __HIP_MEMORY_SCOPE_AGENT); }
        if (l == 16) __hip_atomic_store(&bwords[XB_TOP], 0u, __ATOMIC_RELAXED, __HIP_MEMORY_SCOPE_AGENT);
        if (l == 17) __hip_atomic_store(&bwords[XB_TOPGEN], 0u, __ATOMIC_RELAXED, __HIP_MEMORY_SCOPE_AGENT);
        if (l == 18) __hip_atomic_store(&bwords[XB_TMO], 0u, __ATOMIC_RELAXED, __HIP_MEMORY_SCOPE_AGENT);
        if (l == 19) __hip_atomic_store(idone, 0u, __ATOMIC_RELAXED, __HIP_MEMORY_SCOPE_AGENT);
        if (l >= 32) __hip_atomic_store(pcnt + 64 * (l - 32), 0u, __ATOMIC_RELAXED, __HIP_MEMORY_SCOPE_AGENT);
        asm volatile("s_waitcnt vmcnt(0)" ::: "memory");
        __builtin_amdgcn_fence(__ATOMIC_RELEASE, "agent");
        asm volatile("s_waitcnt vmcnt(0)" ::: "memory");
        if (l == 0) __hip_atomic_store(iflag, INIT_TOKEN, __ATOMIC_RELEASE, __HIP_MEMORY_SCOPE_AGENT);
    }
    __syncthreads();
    const int G = gridDim.x, bx = blockIdx.x;
#define PHASE_IDS() int tid = threadIdx.x; asm volatile("" : "+v"(tid)); const int lane = tid & 63, wid = __builtin_amdgcn_readfirstlane(tid >> 6); (void)lane; (void)wid
    unsigned char* ws = A.ws;
    bf16_t* W1T = (bf16_t*)(ws + WS_W1T); bf16_t* W3T = (bf16_t*)(ws + WS_W3T); bf16_t* WPT = (bf16_t*)(ws + WS_WPT);
    bf16_t* HN = (bf16_t*)(ws + WS_HN); bf16_t* Z = (bf16_t*)(ws + WS_Z); bf16_t* VLN = (bf16_t*)(ws + WS_VLN); bf16_t* Y = (bf16_t*)(ws + WS_Y);
    float* PART = (float*)(ws + WS_PART); f32x2* CARRY = (f32x2*)(ws + WS_CARRY); float* HMETA = (float*)(ws + WS_CARRY + 512 * 1024);

    for (int rep = 0; rep <= PROBE_P0; ++rep) {
        PHASE_IDS();
        LAS float* scr = (LAS float*)(lds + wid * 8448);
        const int gw = bx * 8 + wid, NGW = G * 8;
        constexpr int I1 = (DM / 64) * (NIN / 32);
        for (int it = gw; it < I1; it += NGW) p0_transpose_item<true>(A.w_in, DM, NIN, W1T, scr, it, lane);
        for (int m = gw; m < MX + NMETA; m += NGW) {
            u32x2* o8 = (u32x2*)(HN + (size_t)m * DM) + lane;
            if (m >= MX + NMETA) {
#pragma unroll
                for (int j = 0; j < 8; ++j) o8[64 * j] = (u32x2){0u, 0u};
                continue; }
            const float* src = m < MX ? A.x + (size_t)m * DM : A.meta + (size_t)(m - MX) * DM;
            const f32x4* s4 = (const f32x4*)src + lane; f32x4 v[8]; float ss = 0.f;
#pragma unroll
            for (int j = 0; j < 8; ++j) { v[j] = __builtin_nontemporal_load(s4 + 64 * j); ss += (v[j][0] * v[j][0] + v[j][1] * v[j][1]) + (v[j][2] * v[j][2] + v[j][3] * v[j][3]); }
            const float rstd = 1.0f / sqrtf(wave_sum(ss) * (1.0f / DM) + EPS);
            const f32x4* w4 = (const f32x4*)A.pre_w + lane;
#pragma unroll
            for (int j = 0; j < 8; ++j) { const f32x4 w = w4[64 * j]; o8[64 * j] = (u32x2){cvt_pk_bf16(v[j][0] * rstd * w[0], v[j][1] * rstd * w[1]), cvt_pk_bf16(v[j][2] * rstd * w[2], v[j][3] * rstd * w[3])}; }
        }
    }
    if (threadIdx.x == 0) { unsigned sp = 0; while (__hip_atomic_load(iflag, __ATOMIC_RELAXED, __HIP_MEMORY_SCOPE_AGENT) != INIT_TOKEN) { __builtin_amdgcn_s_sleep(2); if (++sp > (1u << 22)) break; }
        __builtin_amdgcn_fence(__ATOMIC_ACQUIRE, "agent"); }
    __syncthreads();
    const XcdBarrier gbar = xcd_barrier_post(bwords, (volatile LAS unsigned*)(lds + L_MISC));
    xcd_barrier(gbar, 1u);

    for (int rep = 0; rep <= PROBE_P1; ++rep) {
        {
            PHASE_IDS();
            const int r = lane & 15, kq = lane >> 4; const int job = bx; const bool glu = job >= 192;
            int n1, n2 = 0;
            if (!glu) n1 = 16 * job < ZC_U1 ? 16 * job : 16 * job + 2048;
            else { const int ch0 = 16 * (job - 192); n1 = ZC_U1 + 256 * (ch0 >> 7) + (ch0 & 127); n2 = n1 + 128; }
            const bf16_t* ap = HN + (size_t)(MX + r) * DM + 8 * kq + 256 * wid;
            const bf16_t* bp1 = W1T + (size_t)(n1 + r) * DM + 8 * kq + 256 * wid; const bf16_t* bp2 = W1T + (size_t)(n2 + r) * DM + 8 * kq + 256 * wid;
            f32x4 c1 = (f32x4){0.f, 0.f, 0.f, 0.f}, c2 = (f32x4){0.f, 0.f, 0.f, 0.f};
            if (job < 256) {
#pragma unroll
                for (int ks = 0; ks < 8; ++ks) { const bf16x8 av = *(const bf16x8*)(ap + 32 * ks); const bf16x8 b1 = *(const bf16x8*)(bp1 + 32 * ks);
                    c1 = __builtin_amdgcn_mfma_f32_16x16x32_bf16(av, b1, c1, 0, 0, 0);
                    if (glu) { const bf16x8 b2 = *(const bf16x8*)(bp2 + 32 * ks); c2 = __builtin_amdgcn_mfma_f32_16x16x32_bf16(av, b2, c2, 0, 0, 0); } }
                LAS f32x4* red = (LAS f32x4*)lds;
                red[(wid * 2 + 0) * 64 + lane] = c1; red[(wid * 2 + 1) * 64 + lane] = c2;
            }
            __syncthreads();
            if (job < 256 && wid == 0) { const LAS f32x4* red = (const LAS f32x4*)lds; f32x4 t1 = red[lane], t2 = red[64 + lane];
#pragma unroll
                for (int w = 1; w < 8; ++w) { t1 += red[(w * 2 + 0) * 64 + lane]; t2 += red[(w * 2 + 1) * 64 + lane]; }
                if (!glu) { const float bb = A.b_in[n1 + r];
#pragma unroll
                    for (int j = 0; j < 4; ++j) Z[(size_t)(MX + 4 * kq + j) * NIN + n1 + r] = (bf16_t)(cvt_pk_bf16(t1[j] + bb, 0.f) & 0xffffu); }
                else { const int ch = 16 * (job - 192) + r; const float b1 = A.b_in[ZC_U1 + ch], b2 = A.b_in[ZC_U2 + ch];
#pragma unroll
                    for (int j = 0; j < 4; ++j) Z[(size_t)(MX + 4 * kq + j) * NIN + ZC_U1 + ch] = (bf16_t)(cvt_pk_bf16((t1[j] + b1) * sigm(t2[j] + b2), 0.f) & 0xffffu); } }
            __syncthreads();
        }
        { pg8::EpiZ E{Z, NIN, A.b_in, 0}; pg8::StaticOrder S; S.init(MX, ZC_GC, G, bx);
          pg8::Gemm g{HN, W1T, MX, ZC_GC, DM}; pg8::gemm_phase<pg8::EpiZ, pg8::StaticOrder, true>(lds, g, S, E); }
    }
    const bool split2 = (2 * (MX / 256) * ((NIN - ZC_GC) / 256) == G) && bx < G / 2;
    if (split2) xcd_barrier_arrive(gbar); else xcd_barrier(gbar, 2u);

    if (2 * (MX / 256) * ((NIN - ZC_GC) / 256) == G) {
        if (bx < G / 2) { pg8::EpiZ E{Z, NIN, A.b_in, ZC_GC / 256}; pg8::StaticOrder S; S.init(MX, NIN - ZC_GC, G / 2, bx);
            pg8::Gemm g{HN, W1T + (size_t)ZC_GC * DM, MX, NIN - ZC_GC, DM}; pg8::gemm_phase<pg8::EpiZ, pg8::StaticOrder, true>(lds, g, S, E);
            xcd_barrier_wait(gbar, 2u); }
        else { { const int j = bx - G / 2, t = (j & 7) * (G / 16) + (j >> 3);
                 for (int ti = t; ti < MX / 32; ti += G / 2) conf_tile(A, Z, VLN, lds, ti); }
            if (bx - G / 2 < 16) { PHASE_IDS(); const int mh = bx - G / 2;
                lru_fill_tables(A, mh, lds, tid);
                __syncthreads();
                if (wid == 0) { float cP[4] = {1.f, 1.f, 1.f, 1.f}, cH[4] = {0.f, 0.f, 0.f, 0.f}; float dH[4][4], dP[4][4];
                    lru_mtile<false, false>(Z, 0, mh, 0, lds, lds, lds + L_XT, lane, cP, cH, dH, dP);
                    if (lane < 16) {
#pragma unroll
                        for (int ct = 0; ct < 4; ++ct) HMETA[mh * 64 + 16 * ct + lane] = cH[ct]; } }
                __syncthreads(); }
            else { PHASE_IDS();
                LAS float* scr = (LAS float*)(lds + wid * 8448);
                const int gw = (bx - G / 2 - 16) * 8 + wid, NGW = (G / 2 - 16) * 8;
                constexpr int I3 = (DM / 64) * (DM / 32), IP = (DC / 64) * (DC / 32);
                for (int it = gw; it < I3 + IP; it += NGW) { if (it < I3) p0_transpose_item<false>(A.w_out, DM, DM, W3T, scr, it, lane); else p0_transpose_item<false>(A.cpw, DC, DC, WPT, scr, it - I3, lane); } } }
    } else {
        { pg8::EpiZ E{Z, NIN, A.b_in, ZC_GC / 256}; pg8::StaticOrder S; S.init(MX, NIN - ZC_GC, G, bx);
          pg8::Gemm g{HN, W1T + (size_t)ZC_GC * DM, MX, NIN - ZC_GC, DM}; pg8::gemm_phase<pg8::EpiZ, pg8::StaticOrder, true>(lds, g, S, E); }
        for (int ti = bx; ti < MX / 32; ti += G) conf_tile(A, Z, VLN, lds, ti);
    }
    __syncthreads();

    const int ub = bx >> 6, uh = (bx >> 2) & 15, uq = bx & 3;
    float sH[4][4][4], sP[4][4][4];
    for (int rep = 0; rep <= PROBE_P2B; ++rep) {
        if (rep) __syncthreads();
        PHASE_IDS();
        { u32x4 tv[9];
#pragma unroll
          for (int it = 0; it < 9; ++it) { const int idx = tid + 512 * it; const int row = idx >> 3, c = idx & 7; tv[it] = (u32x4){0u, 0u, 0u, 0u};
              if (idx < XS_ROWS * 8) tv[it] = *(const u32x4*)(zrow(Z, ub, NMETA + 512 * uq - 3 + row) + ZC_XL + 64 * uh + 8 * c); }
#pragma unroll
          for (int it = 0; it < 9; ++it) { const int idx = tid + 512 * it; const int row = idx >> 3, c = idx & 7;
              if (idx < XS_ROWS * 8) *(LAS u32x4*)(lds + L_XS + row * XS_STRIDE + c * 16) = tv[it]; } }
        lru_fill_tables(A, uh, lds, tid);
        __syncthreads();
        LAS unsigned char* xt = lds + L_XT + wid * XT_BYTES;
        float cP[4] = {1.f, 1.f, 1.f, 1.f}, cH[4] = {0.f, 0.f, 0.f, 0.f};
        const int hb0 = NMETA + 512 * uq + 64 * wid;
#pragma unroll
        for (int mt = 0; mt < 4; ++mt) lru_mtile<true, true>(Z, ub, uh, hb0 + 16 * mt, lds + L_XS + (64 * wid + 16 * mt) * XS_STRIDE, lds, xt, lane, cP, cH, sH[mt], sP[mt]);
        LAS f32x2* wt = (LAS f32x2*)(lds + L_WT);
        if (lane < 16) {
#pragma unroll
            for (int ct = 0; ct < 4; ++ct) wt[wid * 64 + 16 * ct + lane] = (f32x2){cP[ct], cH[ct]}; }
        __syncthreads();
        if (tid < 64) { float P = 1.f, H = 0.f;
#pragma unroll
            for (int w = 0; w < 8; ++w) { const f32x2 t = wt[w * 64 + tid]; H = H * t.x + t.y; P = P * t.x; }
            CARRY[((ub * 16 + uh) * 4 + uq) * 64 + tid] = (f32x2){P, H}; }
    }
    xcd_barrier(gbar, 3u);

    {
        PHASE_IDS();
        const LAS f32x2* wt = (const LAS f32x2*)(lds + L_WT);
        LAS unsigned char* yt = lds + L_YT + wid * YT_BYTES;
        const int r = lane & 15, kq = lane >> 4;
#pragma unroll
        for (int ct = 0; ct < 4; ++ct) { const int c = 16 * ct + r; float hin = HMETA[uh * 64 + c];
            for (int q = 0; q < uq; ++q) { const f32x2 t = CARRY[((ub * 16 + uh) * 4 + q) * 64 + c]; hin = hin * t.x + t.y; }
            for (int w = 0; w < wid; ++w) { const f32x2 t = wt[w * 64 + c]; hin = hin * t.x + t.y; }
#pragma unroll
            for (int mt = 0; mt < 4; ++mt)
#pragma unroll
                for (int j = 0; j < 4; ++j) { const float hv = sH[mt][ct][j] + sP[mt][ct][j] * hin;
                    *(LAS unsigned short*)(yt + (16 * mt + 4 * kq + j) * YT_STRIDE + c * 2) = (unsigned short)(cvt_pk_bf16(hv, 0.f) & 0xffffu); } }
        asm volatile("s_waitcnt lgkmcnt(0)" ::: "memory");
        __builtin_amdgcn_wave_barrier();
#pragma unroll
        for (int i = 0; i < 8; ++i) { const int piece = lane + 64 * i, tl = piece >> 3, c8 = piece & 7;
            const u32x4 hv = *(const LAS u32x4*)(yt + tl * YT_STRIDE + c8 * 16);
            const size_t row = (size_t)ub * SEQ + 512 * uq + 64 * wid + tl;
            const u32x4 g = *(const u32x4*)(Z + row * NIN + ZC_GL + 64 * uh + 8 * c8);
            u32x4 o;
            o.x = cvt_pk_bf16(bf_lo(hv.x) * siluf(bf_lo(g.x)), bf_hi(hv.x) * siluf(bf_hi(g.x)));
            o.y = cvt_pk_bf16(bf_lo(hv.y) * siluf(bf_lo(g.y)), bf_hi(hv.y) * siluf(bf_hi(g.y)));
            o.z = cvt_pk_bf16(bf_lo(hv.z) * siluf(bf_lo(g.z)), bf_hi(hv.z) * siluf(bf_hi(g.z)));
            o.w = cvt_pk_bf16(bf_lo(hv.w) * siluf(bf_lo(g.w)), bf_hi(hv.w) * siluf(bf_hi(g.w)));
            *(u32x4*)(Y + row * DM + 64 * uh + 8 * c8) = o; }
    }
    __syncthreads();

    for (int rep = 0; rep <= PROBE_P3; ++rep) {
        pg8::EpiPW E{Y, Z, A.cpb};
        pg8::StaticOrder S; S.init(MX, DC, G, bx);
        if (2 * S.nwg == G) { pg8::Unit u; S.at((bx & 7) + 8 * (bx >> 4), u); const int rowbase = u.pm * 256 + 128 * ((bx >> 3) & 1);
            pg8::gemm_half_phase<pg8::EpiPW>(lds, VLN + (size_t)rowbase * DC, WPT + (size_t)u.pn * 256 * DC, DC, rowbase, u.pn, E); }
        else { pg8::Gemm g{VLN, WPT, MX, DC, DC}; pg8::gemm_phase<pg8::EpiPW, pg8::StaticOrder, true>(lds, g, S, E); }
    }
    xcd_barrier(gbar, 4u);

    {
        pg8::Gemm g{Y, W3T, MX, DM, DM}; pg8::StaticOrder S; S.init(MX, DM, G, bx);
        pg8::EpiOut E{A.x, A.out, A.post_w, PART, pcnt};
        pg8::gemm_phase<pg8::EpiOut, pg8::StaticOrder, false>(lds, g, S, E);
    }
    __syncthreads();
    if (threadIdx.x == 0) { const unsigned old = __hip_atomic_fetch_add(idone, 1u, __ATOMIC_RELAXED, __HIP_MEMORY_SCOPE_AGENT); if (old + 1u == (unsigned)G) __hip_atomic_store(iflag, 0u, __ATOMIC_RELAXED, __HIP_MEMORY_SCOPE_AGENT); }
}

extern "C" void kernel_launch(void* const* d_in, const int* in_sizes, int n_in, void* d_out, int out_size, void* d_ws, size_t ws_size, hipStream_t stream) {
    static int grid = 0;
    if (grid == 0) {
        if (n_in != 20 || out_size != MX * DM || ws_size < WS_END) { fprintf(stderr, "kernel_launch: unexpected problem shape (n_in %d out %d ws %zu)\n", n_in, out_size, ws_size); grid = -1; return; }
        int dev = 0, cus = 0, per_cu = 0;
        hipGetDevice(&dev); hipDeviceGetAttribute(&cus, hipDeviceAttributeMultiprocessorCount, dev);
        if (hipFuncSetAttribute((const void*)mega, hipFuncAttributeMaxDynamicSharedMemorySize, LDS_BYTES) != hipSuccess) { fprintf(stderr, "kernel_launch: hipFuncSetAttribute failed\n"); grid = -1; return; }
        hipOccupancyMaxActiveBlocksPerMultiprocessor(&per_cu, (const void*)mega, 512, LDS_BYTES);
        if (cus * per_cu < 256) { fprintf(stderr, "kernel_launch: need 256 resident workgroups, device offers %d x %d\n", cus, per_cu); grid = -1; return; }
        grid = 256;
    }
    if (grid < 0) return;
    Args a{};
    const float** ap = (const float**)&a;
    for (int i = 0; i < 20; ++i) ap[i] = (const float*)d_in[i];
    a.out = (float*)d_out; a.ws = (unsigned char*)d_ws;
    void* args[] = {&a};
    hipError_t e = hipLaunchCooperativeKernel((const void*)mega, dim3(grid), dim3(512), args, LDS_BYTES, stream);
    if (e != hipSuccess) fprintf(stderr, "cooperative launch failed: %s\n", hipGetErrorString(e));
}
```

```cpp
#include <hip/hip_runtime.h>
#include <cstdio>
#include <cstdint>
#include <utility>

#define LAS __attribute__((address_space(3)))
typedef unsigned short bf16_t;
typedef short bf16x8 __attribute__((ext_vector_type(8)));
typedef float f32x4 __attribute__((ext_vector_type(4)));
typedef float f32x2 __attribute__((ext_vector_type(2)));
typedef unsigned u32x4 __attribute__((ext_vector_type(4)));
typedef unsigned u32x2 __attribute__((ext_vector_type(2)));

constexpr int DM = 2048, NBATCH = 4, SEQ = 2048, NMETA = 16, MX = NBATCH * SEQ  , MPAD = MX + 256  , NIN = 5120, DL = 1024, DC = 1024;
constexpr int ZC_XL = 0, ZC_GL = 1024, ZC_U1 = 2048, ZC_U2 = 3072, ZC_GC = 4096;
constexpr float EPS = 1e-6f;
constexpr size_t MiB = 1u << 20;
constexpr size_t WS_W1T = 1 * MiB;
constexpr size_t WS_W3T = 22 * MiB;
constexpr size_t WS_WPT = 30 * MiB;
constexpr size_t WS_HN = 32 * MiB;
constexpr size_t WS_Z = 66 * MiB;
constexpr size_t WS_VLN = 150 * MiB;
constexpr size_t WS_Y = 166 * MiB;
constexpr size_t WS_PART = 198 * MiB;
constexpr size_t WS_CARRY = 199 * MiB;
constexpr size_t WS_END = 200 * MiB;
static_assert(WS_W1T + (size_t)NIN * DM * 2 <= WS_W3T && WS_HN + (size_t)MPAD * DM * 2 <= WS_Z && WS_Z + (size_t)MPAD * NIN * 2 <= WS_VLN, "ws map");
constexpr int LDS_BYTES = 149504, L_MISC = 148480;
constexpr size_t WS_CTL = 0, CTL_BYTES = 32768;
constexpr unsigned INIT_TOKEN = 0x5EEDC0DEu;
constexpr int PROBE_SYNC = 0, PROBE_P0 = 0, PROBE_P1 = 0, PROBE_P2B = 0, PROBE_P3 = 0;

__device__ __forceinline__ unsigned cvt_pk_bf16(float lo, float hi) { unsigned r; asm volatile("v_cvt_pk_bf16_f32 %0, %1, %2" : "=v"(r) : "v"(lo), "v"(hi)); return r; }
__device__ __forceinline__ float bf_lo(unsigned w) { return __uint_as_float(w << 16); }
__device__ __forceinline__ float bf_hi(unsigned w) { return __uint_as_float(w & 0xffff0000u); }
__device__ __forceinline__ float sigm(float x) { return __builtin_amdgcn_rcpf(1.0f + __expf(-x)); }
__device__ __forceinline__ float siluf(float x) { return x * sigm(x); }


#define XB_TMO      128
#define XB_XCNT(j)  (256  + 64 * (j))
#define XB_XSUB(j)  (1280 + 64 * (j))
#define XB_XGEN(j)  (2304 + 64 * (j))
#define XB_TOP      3328
#define XB_TOPGEN   3392
#define XCD_BAR_WORDS 3456
#define XB_SPIN_CAP (1u << 18)
__device__ __forceinline__ unsigned xb_ld(unsigned* p)              { return __hip_atomic_load(p, __ATOMIC_RELAXED, __HIP_MEMORY_SCOPE_AGENT); }
__device__ __forceinline__ unsigned xb_add(unsigned* p, unsigned v) { return __hip_atomic_fetch_add(p, v, __ATOMIC_RELAXED, __HIP_MEMORY_SCOPE_AGENT); }
__device__ __forceinline__ unsigned xb_xcc_id() { return (unsigned)__builtin_amdgcn_s_getreg((3 << 11) | 20) & 0xFu; }
#define XB_SPIN(cond, bar) do { unsigned _sp = 0; while (cond) { __builtin_amdgcn_s_sleep(1); \
    if ((++_sp & 255u) == 0u) { if (xb_ld(&(bar)[XB_TMO])) break; if (_sp > XB_SPIN_CAP) { atomicAdd(&(bar)[XB_TMO], 1u); break; } } } } while (0)
struct XcdBarrier { unsigned* bar; unsigned x; volatile LAS unsigned* st; };
__device__ __forceinline__ XcdBarrier xcd_barrier_post(unsigned* bar, volatile LAS unsigned* st) {
    XcdBarrier b; b.bar = bar; b.x = xb_xcc_id(); b.st = st;
    if (threadIdx.x == 0) (void)xb_add(&bar[XB_XCNT(b.x)], 1u);
    return b;
}
__device__ __forceinline__ void xcd_barrier_complete(unsigned* bar, unsigned x, unsigned& nloc, unsigned& nx) {
    const unsigned G = gridDim.x * gridDim.y * gridDim.z;
    unsigned sum, cnt, mine, sp = 0u;
    for (;;) {
        sum = 0u; cnt = 0u; mine = 0u;
#pragma unroll
        for (unsigned j = 0; j < 16; ++j) { const unsigned c = xb_ld(&bar[XB_XCNT(j)]); sum += c; cnt += (c > 0u) ? 1u : 0u; mine = (j == x) ? c : mine; }
        if (sum == G) break;
        __builtin_amdgcn_s_sleep(1);
        if ((++sp & 255u) == 0u) { if (xb_ld(&bar[XB_TMO])) break; if (sp > XB_SPIN_CAP) { atomicAdd(&bar[XB_TMO], 1u); break; } }
    }
    nloc = mine > 0u ? mine : 1u; nx = cnt > 0u ? cnt : 1u;
}
__device__ __forceinline__ void xcd_barrier_arrive(const XcdBarrier& b) {
    asm volatile("s_waitcnt vmcnt(0)" ::: "memory");
    __syncthreads();
    if (threadIdx.x == 0) {
        unsigned* bar = b.bar;
        __builtin_amdgcn_s_waitcnt(0);
        unsigned nloc = b.st[0], nx = b.st[1];
        if (nloc == 0u) { xcd_barrier_complete(bar, b.x, nloc, nx); b.st[0] = nloc; b.st[1] = nx; }
        const unsigned old = xb_add(&bar[XB_XSUB(b.x)], 1u);
        const unsigned gen = old / nloc;
        if (old + 1u == (gen + 1u) * nloc) {
            __builtin_amdgcn_fence(__ATOMIC_RELEASE, "agent");
            asm volatile("s_waitcnt vmcnt(0)" ::: "memory");
            const unsigned og = xb_add(&bar[XB_TOP], 1u);
            const unsigned tg = og / nx;
            if (og + 1u == (tg + 1u) * nx) {
#pragma unroll
                for (int j = 0; j < 16; ++j) (void)__hip_atomic_fetch_add(&bar[XB_XGEN(j)], 1u, __ATOMIC_RELAXED, __HIP_MEMORY_SCOPE_AGENT);
            }
        }
    }
}
__device__ __forceinline__ void xcd_barrier_wait(const XcdBarrier& b, unsigned k) {
    if (threadIdx.x == 0) {
        unsigned* bar = b.bar;
        XB_SPIN((int)(xb_ld(&bar[XB_XGEN(b.x)]) - k) < 0, bar);
        __builtin_amdgcn_fence(__ATOMIC_ACQUIRE, "agent");
        asm volatile("s_waitcnt vmcnt(0)" ::: "memory");
    }
    __syncthreads();
}
__device__ __forceinline__ void xcd_barrier(const XcdBarrier& b, unsigned k) { xcd_barrier_arrive(b); xcd_barrier_wait(b, k); }

namespace pg8 {
#define PG8_LAS __attribute__((address_space(3)))
constexpr int BM = 256, BK = 64, HALF = 128, HTB = HALF * BK * 2, STAGE_BYTES = 8 * HTB, NXCD = 8, WGM = 8;
__host__ __device__ __forceinline__ int lds_byte(int r, int c) { const int st = (r >> 4) * 2 + (c >> 5), rr = r & 15, cc = c & 31, ob = rr * 64 + cc * 2; return st * 1024 + (ob ^ (((ob >> 9) & 1) << 5)); }
__host__ __device__ __forceinline__ void stage_rc(int b, int& R, int& C) { const int st = b / 1024, sb = b % 1024, swz = sb ^ (((sb >> 9) & 1) << 5); R = (st >> 1) * 16 + swz / 64; C = (st & 1) * 32 + (swz % 64) / 2; }
__host__ __device__ __forceinline__ int perm32(int rho) { const int n = rho >> 4, i = rho & 15; return 8 * (i >> 2) + 4 * n + (i & 3); }
struct Unit { int pm, pn; };
struct Gemm { const bf16_t* A; const bf16_t* Bt; int M, N, K; };
struct StaticOrder {
    int nM, nN, nwg, G, c, nlim;
    __host__ __device__ void init(int M, int N, int G_, int c_) { nM = M / BM; nN = N / BM; nwg = nM * nN; G = G_; c = c_; nlim = nwg; }
    __host__ __device__ bool at(long L, Unit& u) const {
        int wgid = (int)L; { const int q = nwg / NXCD, r = nwg % NXCD, xcd = wgid % NXCD, off = wgid / NXCD; wgid = (xcd < r ? xcd * (q + 1) : r * (q + 1) + (xcd - r) * q) + off; }
        const int nig = WGM * nN, gid = wgid / nig, fm = gid * WGM, gsz = (nM - fm) < WGM ? (nM - fm) : WGM;
        u.pm = fm + ((wgid % nig) % gsz); u.pn = (wgid % nig) / gsz; return true;
    }
    __host__ __device__ bool next(int i, Unit& u) const { const long L = (long)i * G + c; if (L >= nlim) return false; return at(L, u); }
    __device__ __forceinline__ void a_ready(const Unit&) const {}
    __device__ __forceinline__ void done(const Unit&) const {}
};
struct EpiZ {
    static constexpr bool PERM = true, AFTER_DRAIN = false;
    bf16_t* O; int ldc; const float* bias; int pn_off;
    template <int NAI> __device__ __forceinline__ void run(const f32x4 (&acc)[NAI][2][4][2], int rowbase, int pn_, int wr, int wc, int fr, int fq) const {
        const int row0 = rowbase + wr * 64 + fr; const int pn = pn_ + pn_off;
        const bool glu = (pn >= 8 && pn < 16);
        const int cin = wc * 32 + 8 * fq;
        const int bc0 = glu ? ZC_U1 + 128 * (pn - 8) + cin : pn * BM + cin;
        const int bc1 = glu ? ZC_U2 + 128 * (pn - 8) + cin : pn * BM + HALF + cin;
        f32x4 bv[2][2];
#pragma unroll
        for (int n = 0; n < 2; ++n) { bv[0][n] = *(const f32x4*)(bias + bc0 + 4 * n); bv[1][n] = *(const f32x4*)(bias + bc1 + 4 * n); }
        if (glu) {
#pragma unroll
            for (int ai = 0; ai < NAI; ++ai)
#pragma unroll
                for (int m = 0; m < 4; ++m) { bf16_t* rowp = O + (size_t)(row0 + ai * HALF + m * 16) * ldc + bc0;
                    const f32x4 a0 = acc[ai][0][m][0] + bv[0][0], a1 = acc[ai][0][m][1] + bv[0][1], g0 = acc[ai][1][m][0] + bv[1][0], g1 = acc[ai][1][m][1] + bv[1][1];
                    u32x4 w; w.x = cvt_pk_bf16(a0[0] * sigm(g0[0]), a0[1] * sigm(g0[1])); w.y = cvt_pk_bf16(a0[2] * sigm(g0[2]), a0[3] * sigm(g0[3]));
                    w.z = cvt_pk_bf16(a1[0] * sigm(g1[0]), a1[1] * sigm(g1[1])); w.w = cvt_pk_bf16(a1[2] * sigm(g1[2]), a1[3] * sigm(g1[3]));
                    *(u32x4*)rowp = w; }
        } else {
#pragma unroll
            for (int ai = 0; ai < NAI; ++ai)
#pragma unroll
                for (int m = 0; m < 4; ++m) { bf16_t* rowp = O + (size_t)(row0 + ai * HALF + m * 16) * ldc + bc0;
#pragma unroll
                    for (int bj = 0; bj < 2; ++bj) { const f32x4 v0 = acc[ai][bj][m][0] + bv[bj][0], v1 = acc[ai][bj][m][1] + bv[bj][1];
                        u32x4 w; w.x = cvt_pk_bf16(v0[0], v0[1]); w.y = cvt_pk_bf16(v0[2], v0[3]); w.z = cvt_pk_bf16(v1[0], v1[1]); w.w = cvt_pk_bf16(v1[2], v1[3]);
                        *(u32x4*)(rowp + bj * HALF) = w; } }
        }
    }
};
struct EpiPW {
    static constexpr bool PERM = true, AFTER_DRAIN = false;
    bf16_t* Y; const bf16_t* Z; const float* bias;
    template <int NAI> __device__ __forceinline__ void run(const f32x4 (&acc)[NAI][2][4][2], int rowbase, int pn, int wr, int wc, int fr, int fq) const {
        const int row0 = rowbase + wr * 64 + fr; const int col0 = pn * BM + wc * 32 + 8 * fq;
        f32x4 bv[2][2];
#pragma unroll
        for (int bj = 0; bj < 2; ++bj)
#pragma unroll
            for (int n = 0; n < 2; ++n) bv[bj][n] = *(const f32x4*)(bias + col0 + bj * HALF + 4 * n);
#pragma unroll
        for (int ai = 0; ai < NAI; ++ai)
#pragma unroll
            for (int m = 0; m < 4; ++m) { const size_t row = (size_t)(row0 + ai * HALF + m * 16);
#pragma unroll
                for (int bj = 0; bj < 2; ++bj) { const f32x4 v0 = acc[ai][bj][m][0] + bv[bj][0], v1 = acc[ai][bj][m][1] + bv[bj][1];
                    const u32x4 g = *(const u32x4*)(Z + row * NIN + ZC_GC + col0 + bj * HALF);
                    u32x4 w;
                    w.x = cvt_pk_bf16(v0[0] * siluf(bf_lo(g.x)), v0[1] * siluf(bf_hi(g.x)));
                    w.y = cvt_pk_bf16(v0[2] * siluf(bf_lo(g.y)), v0[3] * siluf(bf_hi(g.y)));
                    w.z = cvt_pk_bf16(v1[0] * siluf(bf_lo(g.z)), v1[1] * siluf(bf_hi(g.z)));
                    w.w = cvt_pk_bf16(v1[2] * siluf(bf_lo(g.w)), v1[3] * siluf(bf_hi(g.w)));
                    *(u32x4*)(Y + row * DM + DL + col0 + bj * HALF) = w; } }
    }
};
struct EpiOut {
    static constexpr bool PERM = false, AFTER_DRAIN = true;
    const float* x; float* out; const float* pw; float* part; unsigned* cnt;
    __device__ __forceinline__ void fused(f32x4 (&acc)[2][2][4][2], const Unit& u, int wr, int wc, int fr, int fq, PG8_LAS unsigned char* lds, int wid, int lane) const {
        PG8_LAS float* P = (PG8_LAS float*)lds;
        PG8_LAS float* S = (PG8_LAS float*)(lds + 8192);
#pragma unroll
        for (int ai = 0; ai < 2; ++ai)
#pragma unroll
            for (int m = 0; m < 4; ++m) { float s = 0.f;
#pragma unroll
                for (int bj = 0; bj < 2; ++bj)
#pragma unroll
                    for (int n = 0; n < 2; ++n) { const f32x4 v = acc[ai][bj][m][n]; s += (v[0] * v[0] + v[1] * v[1]) + (v[2] * v[2] + v[3] * v[3]); }
                s += __shfl_xor(s, 16); s += __shfl_xor(s, 32);
                if (fq == 0) P[(ai * HALF + wr * 64 + m * 16 + fr) * 4 + wc] = s; }
        __syncthreads();
        const int tid = wid * 64 + lane;
        if (tid < 256) { const float t = (P[tid * 4 + 0] + P[tid * 4 + 1]) + (P[tid * 4 + 2] + P[tid * 4 + 3]); __hip_atomic_store(part + (size_t)(u.pm * BM + tid) * 8 + u.pn, t, __ATOMIC_RELAXED, __HIP_MEMORY_SCOPE_AGENT);
            asm volatile("s_waitcnt vmcnt(0)" ::: "memory");
            if (lane == 0) __hip_atomic_fetch_add(cnt + 64 * u.pm, 1u, __ATOMIC_RELAXED, __HIP_MEMORY_SCOPE_AGENT); }
        PG8_LAS float* T = (PG8_LAS float*)(lds + 9216);
        constexpr int TS = 260;
        const size_t gbase = (size_t)(u.pm * BM) * DM + (size_t)u.pn * BM + 4 * lane;
        f32x4 xr[16];
#pragma unroll
        for (int rr = 0; rr < 16; ++rr) xr[rr] = __builtin_nontemporal_load((const f32x4*)(x + gbase + (size_t)(wid * 16 + rr) * DM));
        if (wid == 0) {
            unsigned sp = 0;
            while ((unsigned)__builtin_amdgcn_readfirstlane(__hip_atomic_load(cnt + 64 * u.pm, __ATOMIC_RELAXED, __HIP_MEMORY_SCOPE_AGENT)) < 32u) { __builtin_amdgcn_s_sleep(2); if (++sp > (1u << 22)) break; }
            __builtin_amdgcn_fence(__ATOMIC_ACQUIRE, "agent");
            asm volatile("s_waitcnt vmcnt(0)" ::: "memory");
        }
        __syncthreads();
        if (tid < 256) { const float* pp = part + (size_t)(u.pm * BM + tid) * 8; float t = 0.f;
#pragma unroll
            for (int k = 0; k < 8; ++k) t += __hip_atomic_load(pp + k, __ATOMIC_RELAXED, __HIP_MEMORY_SCOPE_AGENT);
            S[tid] = 1.0f / sqrtf(t * (1.0f / (float)DM) + EPS); }
        const f32x4 wv = *(const f32x4*)(pw + u.pn * BM + 4 * lane);
        f32x4 xr2[16];
#pragma unroll
        for (int ai = 0; ai < 2; ++ai) {
            if (ai == 1) __syncthreads();
#pragma unroll
            for (int m = 0; m < 4; ++m)
#pragma unroll
                for (int bj = 0; bj < 2; ++bj)
#pragma unroll
                    for (int n = 0; n < 2; ++n) *(PG8_LAS f32x4*)(T + (wr * 64 + m * 16 + fr) * TS + bj * HALF + wc * 32 + n * 16 + 4 * fq) = acc[ai][bj][m][n];
            if (ai == 0) {
#pragma unroll
                for (int rr = 0; rr < 16; ++rr) xr2[rr] = __builtin_nontemporal_load((const f32x4*)(x + gbase + (size_t)(HALF + wid * 16 + rr) * DM));
            }
            __syncthreads();
#pragma unroll
            for (int rr = 0; rr < 16; ++rr) { const int rl = wid * 16 + rr; const float rs = S[ai * HALF + rl];
                const f32x4 y = *(const PG8_LAS f32x4*)(T + rl * TS + 4 * lane);
                const f32x4 o = (ai == 0 ? xr[rr] : xr2[rr]) + y * rs * wv;
                __builtin_nontemporal_store(o, (f32x4*)(out + gbase + (size_t)(ai * HALF + rl) * DM)); }
        }
    }
};

template <class Epi, class Sched, bool ALIGN_EPI = false>
__device__ __forceinline__ void gemm_phase(PG8_LAS unsigned char* lds, const Gemm g, const Sched& S, const Epi& E) {
    int tid = threadIdx.x; asm volatile("" : "+v"(tid));
    const int wid = __builtin_amdgcn_readfirstlane(tid >> 6), lane = tid & 63, wr = wid >> 2, wc = wid & 3, fr = lane & 15, fq = lane >> 4;
    const int K = g.K, nt = K / BK;
    unsigned voffA[2], voffB[2];
#pragma unroll
    for (int i = 0; i < 2; ++i) { int R, C; stage_rc(tid * 16 + i * 8192, R, C); const int Rb = Epi::PERM ? ((R & ~31) + perm32(R & 31)) : R;
        voffA[i] = (unsigned)(R * K + C) * 2u; voffB[i] = (unsigned)(Rb * K + C) * 2u; }
    const size_t kstep = (size_t)(BK * 2);
    const size_t hstep = (size_t)HALF * K * 2;
    const size_t tstep = 2 * hstep;
    const unsigned ldsw = (unsigned)wid * 1024u;
    const int aoff = lds_byte(wr * 64 + fr, fq * 8), boff = lds_byte(wc * 32 + fr, fq * 8);
#define PG8_SA(b, h) (((b) * 2 + (h)) * HTB)
#define PG8_SB(b, h) ((4 + (b) * 2 + (h)) * HTB)
#define PG8_STAGE(bufoff, gbase, voff) do { _Pragma("unroll") for (int _i = 0; _i < 2; ++_i) \
        __builtin_amdgcn_global_load_lds((const unsigned*)((const char*)(gbase) + (voff)[_i]), (PG8_LAS unsigned*)(lds + (bufoff) + ldsw + _i * 8192), 16, 0, 0); } while (0)
#define PG8_LDA(dst, b, h) do { _Pragma("unroll") for (int m = 0; m < 4; ++m) _Pragma("unroll") for (int k = 0; k < 2; ++k) dst[m][k] = *(const PG8_LAS bf16x8*)(lds + PG8_SA(b, h) + aoff + m * 2048 + k * 1024); } while (0)
#define PG8_LDB(dst, b, h) do { _Pragma("unroll") for (int n = 0; n < 2; ++n) _Pragma("unroll") for (int k = 0; k < 2; ++k) dst[n][k] = *(const PG8_LAS bf16x8*)(lds + PG8_SB(b, h) + boff + n * 2048 + k * 1024); } while (0)
#define PG8_MMA(ai, bj, At, Bt) do { __builtin_amdgcn_s_setprio(1); _Pragma("unroll") for (int m = 0; m < 4; ++m) _Pragma("unroll") for (int n = 0; n < 2; ++n) _Pragma("unroll") for (int k = 0; k < 2; ++k) \
        acc[ai][bj][m][n] = __builtin_amdgcn_mfma_f32_16x16x32_bf16(Bt[n][k], At[m][k], acc[ai][bj][m][n], 0, 0, 0); __builtin_amdgcn_s_setprio(0); } while (0)
#define PG8_WAIT_V(n) asm volatile("s_waitcnt vmcnt(" #n ")" ::: "memory")
#define PG8_WAIT_L(n) asm volatile("s_waitcnt lgkmcnt(" #n ")" ::: "memory")
#define PG8_BAR __builtin_amdgcn_s_barrier()
#define PG8_SCHED __builtin_amdgcn_sched_barrier(0)
    Unit cur, nxt; int ui = 0;
    if (!S.next(0, cur)) return;
    f32x4 acc[2][2][4][2];
#pragma unroll
    for (int a = 0; a < 2; ++a)
#pragma unroll
        for (int b = 0; b < 2; ++b)
#pragma unroll
            for (int m = 0; m < 4; ++m)
#pragma unroll
                for (int n = 0; n < 2; ++n) acc[a][b][m][n] = (f32x4){0.f, 0.f, 0.f, 0.f};
    bf16x8 At[4][2], B0[2][2], B1[2][2];
    const char* cA = (const char*)g.A + (size_t)cur.pm * tstep; const char* cB = (const char*)g.Bt + (size_t)cur.pn * tstep;
    S.a_ready(cur);
    PG8_STAGE(PG8_SB(0, 0), cB, voffB); PG8_STAGE(PG8_SB(0, 1), cB + hstep, voffB); PG8_STAGE(PG8_SA(0, 0), cA, voffA); PG8_STAGE(PG8_SA(0, 1), cA + hstep, voffA);
    if (wr == 1) PG8_BAR;
    PG8_WAIT_V(2); PG8_BAR;
    PG8_STAGE(PG8_SB(1, 0), cB + kstep, voffB); PG8_STAGE(PG8_SA(1, 0), cA + kstep, voffA); PG8_STAGE(PG8_SB(1, 1), cB + hstep + kstep, voffB);
    PG8_WAIT_V(6); PG8_BAR;
    for (;;) {
        const bool has_next = S.next(ui + 1, nxt);
        const char* nA = has_next ? (const char*)g.A + (size_t)nxt.pm * tstep : cA; const char* nB = has_next ? (const char*)g.Bt + (size_t)nxt.pn * tstep : cB;
        for (int t = 0; t < nt; t += 2) {
            const bool last = (t == nt - 2);
            const char* a1 = cA + (size_t)(t + 1) * kstep;
            const char* a2 = last ? nA : cA + (size_t)(t + 2) * kstep; const char* b2 = last ? nB : cB + (size_t)(t + 2) * kstep;
            const char* a3 = a2 + kstep; const char* b3 = b2 + kstep;
            if (last && has_next) S.a_ready(nxt);
            PG8_LDB(B0, 0, 0); PG8_LDB(B1, 0, 1); PG8_SCHED; PG8_LDA(At, 0, 0); PG8_STAGE(PG8_SA(1, 1), a1 + hstep, voffA);
            PG8_WAIT_V(8); PG8_WAIT_L(0); PG8_BAR; PG8_MMA(0, 0, At, B0); PG8_MMA(0, 1, At, B1); PG8_BAR; PG8_SCHED;
            PG8_LDA(At, 0, 1); PG8_STAGE(PG8_SB(0, 0), b2, voffB); PG8_STAGE(PG8_SB(0, 1), b2 + hstep, voffB); PG8_STAGE(PG8_SA(0, 0), a2, voffA);
            PG8_WAIT_V(8); PG8_WAIT_L(0); PG8_BAR; PG8_MMA(1, 0, At, B0); PG8_MMA(1, 1, At, B1); PG8_BAR; PG8_SCHED;
            PG8_LDB(B0, 1, 0); PG8_LDB(B1, 1, 1); PG8_SCHED; PG8_LDA(At, 1, 0); PG8_STAGE(PG8_SA(0, 1), a2 + hstep, voffA);
            PG8_WAIT_V(8); PG8_WAIT_L(0); PG8_BAR; PG8_MMA(0, 0, At, B0); PG8_MMA(0, 1, At, B1); PG8_BAR; PG8_SCHED;
            PG8_LDA(At, 1, 1); PG8_STAGE(PG8_SB(1, 0), b3, voffB); PG8_STAGE(PG8_SB(1, 1), b3 + hstep, voffB); PG8_STAGE(PG8_SA(1, 0), a3, voffA);
            PG8_WAIT_V(8); PG8_WAIT_L(0); PG8_BAR; PG8_MMA(1, 0, At, B0); PG8_MMA(1, 1, At, B1); PG8_BAR; PG8_SCHED;
        }
        if constexpr (ALIGN_EPI) { if (wr == 0) PG8_BAR; }
        if constexpr (!Epi::AFTER_DRAIN) { E.template run<2>(acc, cur.pm * BM, cur.pn, wr, wc, fr, fq); S.done(cur); }
        if (!has_next) break;
#pragma unroll
        for (int a = 0; a < 2; ++a)
#pragma unroll
            for (int b = 0; b < 2; ++b)
#pragma unroll
                for (int m = 0; m < 4; ++m)
#pragma unroll
                    for (int n = 0; n < 2; ++n) acc[a][b][m][n] = (f32x4){0.f, 0.f, 0.f, 0.f};
        cur = nxt; cA = nA; cB = nB; ++ui;
        if constexpr (ALIGN_EPI) { if (wr == 1) PG8_BAR; }
    }
    PG8_WAIT_V(0);
    if constexpr (!ALIGN_EPI) { if (wr == 0) PG8_BAR; }
    PG8_BAR;
    if constexpr (Epi::AFTER_DRAIN) { E.fused(acc, cur, wr, wc, fr, fq, lds, wid, lane); S.done(cur); }
#undef PG8_SA
#undef PG8_SB
#undef PG8_STAGE
#undef PG8_LDA
#undef PG8_LDB
#undef PG8_MMA
#undef PG8_WAIT_V
#undef PG8_WAIT_L
#undef PG8_BAR
#undef PG8_SCHED
}

template <class Epi>
__device__ __forceinline__ void gemm_half_phase(PG8_LAS unsigned char* lds, const bf16_t* Ah, const bf16_t* Bh, int K, int rowbase, int pn, const Epi& E) {
    int tid = threadIdx.x; asm volatile("" : "+v"(tid));
    const int wid = __builtin_amdgcn_readfirstlane(tid >> 6), lane = tid & 63, wr = wid >> 2, wc = wid & 3, fr = lane & 15, fq = lane >> 4;
    const int nt = K / BK;
    unsigned voffA[2], voffB[2];
#pragma unroll
    for (int i = 0; i < 2; ++i) { int R, C; stage_rc(tid * 16 + i * 8192, R, C); const int Rb = Epi::PERM ? ((R & ~31) + perm32(R & 31)) : R;
        voffA[i] = (unsigned)(R * K + C) * 2u; voffB[i] = (unsigned)(Rb * K + C) * 2u; }
    const size_t kstep = (size_t)(BK * 2);
    const size_t hstep = (size_t)HALF * K * 2;
    const unsigned ldsw = (unsigned)wid * 1024u;
    const int aoff = lds_byte(wr * 64 + fr, fq * 8), boff = lds_byte(wc * 32 + fr, fq * 8);
    constexpr int SST = 3 * HTB;
#define PH_STAGE(bufoff, gbase, voff) do { _Pragma("unroll") for (int _i = 0; _i < 2; ++_i) \
        __builtin_amdgcn_global_load_lds((const unsigned*)((const char*)(gbase) + (voff)[_i]), (PG8_LAS unsigned*)(lds + (bufoff) + ldsw + _i * 8192), 16, 0, 0); } while (0)
#define PH_STAGE_TILE(so, tt) do { PH_STAGE((so) + HTB, cB + (size_t)(tt) * kstep, voffB); PH_STAGE((so) + 2 * HTB, cB + hstep + (size_t)(tt) * kstep, voffB); PH_STAGE((so), cA + (size_t)(tt) * kstep, voffA); } while (0)
#define PH_LDA(dst, so) do { _Pragma("unroll") for (int m = 0; m < 4; ++m) _Pragma("unroll") for (int k = 0; k < 2; ++k) dst[m][k] = *(const PG8_LAS bf16x8*)(lds + (so) + aoff + m * 2048 + k * 1024); } while (0)
#define PH_LDB(dst, so, h) do { _Pragma("unroll") for (int n = 0; n < 2; ++n) _Pragma("unroll") for (int k = 0; k < 2; ++k) dst[n][k] = *(const PG8_LAS bf16x8*)(lds + (so) + HTB + (h) * HTB + boff + n * 2048 + k * 1024); } while (0)
#define PH_MMA(bj, At, Bt) do { __builtin_amdgcn_s_setprio(1); _Pragma("unroll") for (int m = 0; m < 4; ++m) _Pragma("unroll") for (int n = 0; n < 2; ++n) _Pragma("unroll") for (int k = 0; k < 2; ++k) \
        acc[0][bj][m][n] = __builtin_amdgcn_mfma_f32_16x16x32_bf16(Bt[n][k], At[m][k], acc[0][bj][m][n], 0, 0, 0); __builtin_amdgcn_s_setprio(0); } while (0)
#define PH_WAIT_V(n) asm volatile("s_waitcnt vmcnt(" #n ")" ::: "memory")
#define PH_WAIT_L(n) asm volatile("s_waitcnt lgkmcnt(" #n ")" ::: "memory")
#define PH_BAR __builtin_amdgcn_s_barrier()
#define PH_SCHED __builtin_amdgcn_sched_barrier(0)
    f32x4 acc[1][2][4][2];
#pragma unroll
    for (int b = 0; b < 2; ++b)
#pragma unroll
        for (int m = 0; m < 4; ++m)
#pragma unroll
            for (int n = 0; n < 2; ++n) acc[0][b][m][n] = (f32x4){0.f, 0.f, 0.f, 0.f};
    bf16x8 At[4][2], B0[2][2], B1[2][2];
    const char* cA = (const char*)Ah; const char* cB = (const char*)Bh;
    PH_STAGE_TILE(0, 0); PH_STAGE_TILE(SST, 1);
    if (wr == 1) PH_BAR;
    PH_WAIT_V(6); PH_BAR;
    PH_BAR;
    int so = 0, so2 = 2 * SST;
    for (int t = 0; t < nt; ++t) {
        const int t2 = (t + 2 < nt) ? t + 2 : t + 2 - nt;
        PH_LDB(B0, so, 0); PH_LDB(B1, so, 1); PH_SCHED; PH_LDA(At, so); PH_STAGE_TILE(so2, t2);
        PH_WAIT_V(6); PH_WAIT_L(0); PH_BAR; PH_MMA(0, At, B0); PH_MMA(1, At, B1); PH_BAR; PH_SCHED;
        so = (so == 2 * SST) ? 0 : so + SST; so2 = (so2 == 2 * SST) ? 0 : so2 + SST;
    }
    E.template run<1>(acc, rowbase, pn, wr, wc, fr, fq);
    PH_WAIT_V(0);
    if (wr == 0) PH_BAR;
    PH_BAR;
#undef PH_STAGE
#undef PH_STAGE_TILE
#undef PH_LDA
#undef PH_LDB
#undef PH_MMA
#undef PH_WAIT_V
#undef PH_WAIT_L
#undef PH_BAR
#undef PH_SCHED
}
}

__device__ __forceinline__ float wave_sum(float v) {
#pragma unroll
    for (int o = 1; o < 64; o <<= 1) v += __shfl_xor(v, o);
    return v;
}
template <bool GLU_PERM>
__device__ __forceinline__ void p0_transpose_item(const float* W, int K, int N, bf16_t* WT, LAS float* scr, int item, int lane) {
    const int nblk = N / 32, kb = item / nblk, nb = item % nblk, k0 = 64 * kb, n0 = 32 * nb;
    int d0 = n0;
    if (GLU_PERM) { if (n0 >= ZC_U1 && n0 < ZC_U2) { const int ch = n0 - ZC_U1; d0 = ZC_U1 + 256 * (ch >> 7) + (ch & 127); } else if (n0 >= ZC_U2 && n0 < ZC_GC) { const int ch = n0 - ZC_U2; d0 = ZC_U1 + 256 * (ch >> 7) + 128 + (ch & 127); } }
    float tv[32];
#pragma unroll
    for (int i = 0; i < 32; ++i) { const int kk = 2 * i + (lane >> 5); tv[i] = __builtin_nontemporal_load(W + (size_t)(k0 + kk) * N + n0 + (lane & 31)); }
#pragma unroll
    for (int i = 0; i < 32; ++i) { const int kk = 2 * i + (lane >> 5); scr[kk * 33 + (lane & 31)] = tv[i]; }
    asm volatile("s_waitcnt lgkmcnt(0)" ::: "memory");
    const int c = lane & 7;
#pragma unroll
    for (int j = 0; j < 4; ++j) { const int n = (lane >> 3) + 8 * j; const LAS float* s = scr + (8 * c) * 33 + n;
        u32x4 o; o.x = cvt_pk_bf16(s[0 * 33], s[1 * 33]); o.y = cvt_pk_bf16(s[2 * 33], s[3 * 33]); o.z = cvt_pk_bf16(s[4 * 33], s[5 * 33]); o.w = cvt_pk_bf16(s[6 * 33], s[7 * 33]);
        *(u32x4*)(WT + (size_t)(d0 + n) * K + k0 + 8 * c) = o; }
    asm volatile("s_waitcnt lgkmcnt(0)" ::: "memory");
}

struct Args {
    const float *x, *meta, *pre_w, *post_w, *w_in, *b_in, *lcw, *lcb, *wga, *bga, *wgx, *bgx, *lam, *cdw, *cdb, *clw, *clb, *cpw, *cpb, *w_out;
    float* out; unsigned char* ws;
};

__device__ __forceinline__ const bf16_t* zrow(const bf16_t* Z, int b, int hidx) { const int row = hidx < NMETA ? MX + hidx : b * SEQ + hidx - NMETA; return Z + (size_t)row * NIN; }

template <int N> struct RS {
    template <int MASK> static __device__ __forceinline__ void step(float (&v)[64], int lane) {
#pragma unroll
        for (int j = 0; j < N; ++j) { const float lo = v[j], hi = v[j + N]; const bool up = (lane & MASK) != 0; const float send = up ? lo : hi, keep = up ? hi : lo; v[j] = keep + __shfl_xor(send, MASK); }
    }
};

template <int RR> __device__ __forceinline__ void conv_row(f32x2 (&ac)[32], const f32x2 (&wk)[31], const LAS unsigned char* p) {
    const unsigned v = *(const LAS unsigned*)(p + RR * 2048); const f32x2 v2 = (f32x2){bf_lo(v), bf_hi(v)};
    constexpr int lo = RR - 30 > 0 ? RR - 30 : 0, hi = RR < 31 ? RR : 31;
#pragma unroll
    for (int o = lo; o <= hi; ++o) ac[o] = __builtin_elementwise_fma(wk[RR - o], v2, ac[o]);
}
template <int... R> __device__ __forceinline__ void conv_all(f32x2 (&ac)[32], const f32x2 (&wk)[31], const LAS unsigned char* p, std::integer_sequence<int, R...>) { (conv_row<R>(ac, wk, p), ...); }

__device__ __forceinline__ void conf_tile(const Args& A, const bf16_t* Z, bf16_t* VLN, LAS unsigned char* lds, int ti) {
    int tid = threadIdx.x; asm volatile("" : "+v"(tid));
    const int lane = tid & 63, wid = tid >> 6;
    const int b = ti >> 6, t0 = (ti & 63) * 32, i0 = NMETA + t0;
    LAS float* red = (LAS float*)(lds + 126976);
    LAS float* stats = (LAS float*)(lds + 129024);
    f32x2 wk[31];
    { const char* wp = (const char*)(A.cdw + 2 * tid);
#pragma unroll
      for (int k = 0; k < 31; ++k) { wk[k] = *(const f32x2*)wp; wp += DC * 4; asm volatile("" : "+v"(wp)); } }
    { u32x4 tv[16];
#pragma unroll
      for (int it = 0; it < 16; ++it) { const int idx = tid + 512 * it; const int rr = idx >> 7, c8 = idx & 127; const int hidx = i0 - 30 + rr;
          tv[it] = (u32x4){0u, 0u, 0u, 0u};
          if (idx < 62 * 128 && hidx >= 0) tv[it] = *(const u32x4*)(zrow(Z, b, hidx) + ZC_U1 + 8 * c8); }
#pragma unroll
      for (int it = 0; it < 16; ++it) { const int idx = tid + 512 * it; const int rr = idx >> 7, c8 = idx & 127;
          if (idx < 62 * 128) *(LAS u32x4*)(lds + rr * 2048 + c8 * 16) = tv[it]; } }
    __syncthreads();
    f32x2 ac[32];
    { const f32x2 bb = *(const f32x2*)(A.cdb + 2 * tid);
#pragma unroll
      for (int o = 0; o < 32; ++o) ac[o] = bb; }
    conv_all(ac, wk, lds + tid * 4, std::make_integer_sequence<int, 62>{});
    float v[64];
#pragma unroll
    for (int o = 0; o < 32; ++o) { v[2 * o] = ac[o].x + ac[o].y; v[2 * o + 1] = ac[o].x * ac[o].x + ac[o].y * ac[o].y; }
    RS<32>::step<32>(v, lane); RS<16>::step<16>(v, lane); RS<8>::step<8>(v, lane); RS<4>::step<4>(v, lane); RS<2>::step<2>(v, lane); RS<1>::step<1>(v, lane);
    red[wid * 64 + lane] = v[0];
    __syncthreads();
    if (tid < 64) { float s = 0.f;
#pragma unroll
        for (int w = 0; w < 8; ++w) s += red[w * 64 + tid];
        red[tid] = s; }
    __syncthreads();
    if (tid < 32) { const float s1 = red[2 * tid], s2 = red[2 * tid + 1]; const float mean = s1 * (1.0f / DC); const float var = s2 * (1.0f / DC) - mean * mean;
        stats[2 * tid] = mean; stats[2 * tid + 1] = 1.0f / sqrtf(fmaxf(var, 0.f) + EPS); }
    __syncthreads();
    const f32x2 lw = *(const f32x2*)(A.clw + 2 * tid), lb = *(const f32x2*)(A.clb + 2 * tid);
    unsigned* op = (unsigned*)(VLN + (size_t)(b * SEQ + t0) * DC + 2 * tid);
#pragma unroll
    for (int o = 0; o < 32; ++o) { const float mean = stats[2 * o], rstd = stats[2 * o + 1];
        const float y0 = (ac[o].x - mean) * rstd * lw.x + lb.x, y1 = (ac[o].y - mean) * rstd * lw.y + lb.y;
        op[(size_t)o * (DC / 2)] = cvt_pk_bf16(siluf(y0), siluf(y1)); }
    __syncthreads();
}

constexpr int L_WL = 0, L_CW = 16384, L_CST = 17664, L_XT = 18688, XT_STRIDE = 144, XT_BYTES = 16 * XT_STRIDE, L_WT = L_XT + 8 * XT_BYTES;
static_assert(L_WT == 37120, "lds map");
constexpr int L_XS = L_WT + 4096, XS_STRIDE = 144, XS_ROWS = 515, L_YT = L_XS, YT_STRIDE = 144, YT_BYTES = 64 * YT_STRIDE;
static_assert(L_XS + XS_ROWS * XS_STRIDE <= 131072 && L_YT + 8 * YT_BYTES <= 131072 && 61 * XS_STRIDE >= 8448, "lds map");

template <bool STASH, bool FROM_LDS>
__device__ __forceinline__ void lru_mtile(const bf16_t* Z, int b, int h, int hb, const LAS unsigned char* xs, LAS unsigned char* lds, LAS unsigned char* xt, int lane,
                                          float (&cP)[4], float (&cH)[4], float (&sH)[4][4], float (&sP)[4][4]) {
    const int r = lane & 15, kq = lane >> 4;
    const LAS float* cw = (const LAS float*)(lds + L_CW);
    const LAS float* cst = (const LAS float*)(lds + L_CST);
    float xc[2][8];
#pragma unroll
    for (int ks = 0; ks < 2; ++ks) { const f32x4 b0 = *(const LAS f32x4*)(cw + 4 * 64 + 32 * ks + 8 * kq), b1 = *(const LAS f32x4*)(cw + 4 * 64 + 32 * ks + 8 * kq + 4);
        xc[ks][0] = b0[0]; xc[ks][1] = b0[1]; xc[ks][2] = b0[2]; xc[ks][3] = b0[3]; xc[ks][4] = b1[0]; xc[ks][5] = b1[1]; xc[ks][6] = b1[2]; xc[ks][7] = b1[3]; }
#pragma unroll
    for (int k = 0; k < 4; ++k) { const int hidx = hb + r - 3 + k;
        if (FROM_LDS || hidx >= 0) { const bf16_t* rp = zrow(Z, b, hidx < 0 ? 0 : hidx) + ZC_XL + 64 * h + 8 * kq;
#pragma unroll
            for (int ks = 0; ks < 2; ++ks) { u32x4 v;
                if (FROM_LDS) v = *(const LAS u32x4*)(xs + (r + k) * XS_STRIDE + (8 * kq + 32 * ks) * 2); else v = *(const u32x4*)(rp + 32 * ks);
                const f32x4 w0 = *(const LAS f32x4*)(cw + k * 64 + 32 * ks + 8 * kq), w1 = *(const LAS f32x4*)(cw + k * 64 + 32 * ks + 8 * kq + 4);
                xc[ks][0] += w0[0] * bf_lo(v.x); xc[ks][1] += w0[1] * bf_hi(v.x); xc[ks][2] += w0[2] * bf_lo(v.y); xc[ks][3] += w0[3] * bf_hi(v.y);
                xc[ks][4] += w1[0] * bf_lo(v.z); xc[ks][5] += w1[1] * bf_hi(v.z); xc[ks][6] += w1[2] * bf_lo(v.w); xc[ks][7] += w1[3] * bf_hi(v.w); } } }
    bf16x8 af[2];
#pragma unroll
    for (int ks = 0; ks < 2; ++ks) { u32x4 p; p.x = cvt_pk_bf16(xc[ks][0], xc[ks][1]); p.y = cvt_pk_bf16(xc[ks][2], xc[ks][3]); p.z = cvt_pk_bf16(xc[ks][4], xc[ks][5]); p.w = cvt_pk_bf16(xc[ks][6], xc[ks][7]);
        af[ks] = __builtin_bit_cast(bf16x8, p); *(LAS u32x4*)(xt + r * XT_STRIDE + (32 * ks + 8 * kq) * 2) = p; }
    asm volatile("s_waitcnt lgkmcnt(0)" ::: "memory");
    __builtin_amdgcn_wave_barrier();
#pragma unroll
    for (int ct = 0; ct < 4; ++ct) {
        const bf16x8 wa0 = *(const LAS bf16x8*)(lds + L_WL + ((0 * 4 + ct) * 2 + 0) * 1024 + lane * 16), wa1 = *(const LAS bf16x8*)(lds + L_WL + ((0 * 4 + ct) * 2 + 1) * 1024 + lane * 16);
        const bf16x8 wx0 = *(const LAS bf16x8*)(lds + L_WL + ((1 * 4 + ct) * 2 + 0) * 1024 + lane * 16), wx1 = *(const LAS bf16x8*)(lds + L_WL + ((1 * 4 + ct) * 2 + 1) * 1024 + lane * 16);
        f32x4 ra = (f32x4){0.f, 0.f, 0.f, 0.f}, ia = (f32x4){0.f, 0.f, 0.f, 0.f};
        ra = __builtin_amdgcn_mfma_f32_16x16x32_bf16(af[0], wa0, ra, 0, 0, 0); ra = __builtin_amdgcn_mfma_f32_16x16x32_bf16(af[1], wa1, ra, 0, 0, 0);
        ia = __builtin_amdgcn_mfma_f32_16x16x32_bf16(af[0], wx0, ia, 0, 0, 0); ia = __builtin_amdgcn_mfma_f32_16x16x32_bf16(af[1], wx1, ia, 0, 0, 0);
        const f32x4 c4 = *(const LAS f32x4*)(cst + (16 * ct + r) * 4);
        float p[4], hh[4];
#pragma unroll
        for (int j = 0; j < 4; ++j) {
            const float xcv = __uint_as_float((unsigned)(*(const LAS unsigned short*)(xt + (4 * kq + j) * XT_STRIDE + (16 * ct + r) * 2)) << 16);
            const float rr = __builtin_amdgcn_rcpf(1.0f + __builtin_amdgcn_exp2f(__builtin_fmaf(ra[j], -1.44269504f, c4[0])));
            const float ii = __builtin_amdgcn_rcpf(1.0f + __builtin_amdgcn_exp2f(__builtin_fmaf(ia[j], -1.44269504f, c4[1])));
            const float a = __builtin_amdgcn_exp2f(c4[2] * rr);
            const float x2 = c4[3] * rr;
            float om_p = -x2 * __builtin_fmaf(x2, 0.5f, 1.0f), om_b = __builtin_fmaf(-a, a, 1.0f); asm volatile("" : "+v"(om_p), "+v"(om_b));
            const float om = x2 > -2e-3f ? om_p : om_b;
            const float mult = __builtin_amdgcn_sqrtf(om); const float u = mult * ii * xcv;
            if (j == 0) { p[0] = a; hh[0] = u; } else { p[j] = p[j - 1] * a; hh[j] = hh[j - 1] * a + u; } }
        float EP = cP[ct], EH = cH[ct];
#pragma unroll
        for (int q = 0; q < 3; ++q) { float tp = __shfl(p[3], r + 16 * q), th = __shfl(hh[3], r + 16 * q); tp = q < kq ? tp : 1.0f; th = q < kq ? th : 0.0f; EH = EH * tp + th; EP = EP * tp; }
        if (STASH) {
#pragma unroll
            for (int j = 0; j < 4; ++j) { sH[ct][j] = EH * p[j] + hh[j]; sP[ct][j] = EP * p[j]; } }
        const float tP = EP * p[3], tH = EH * p[3] + hh[3];
        cP[ct] = __shfl(tP, r + 48); cH[ct] = __shfl(tH, r + 48);
        if (ct & 1) __builtin_amdgcn_sched_barrier(0);
    }
    __builtin_amdgcn_wave_barrier();
}

__device__ __forceinline__ void lru_fill_tables(const Args& A, int uh, LAS unsigned char* lds, int tid) {
    for (int f = tid; f < 1024; f += 512) { const int l = f & 63, ks = (f >> 6) & 1, ct = (f >> 7) & 3, gsel = f >> 9; const int n = l & 15, kq = l >> 4;
        const float* wsrc = (gsel ? A.wgx : A.wga) + (size_t)uh * 4096 + (size_t)(32 * ks + 8 * kq) * 64 + 16 * ct + n;
        u32x4 p; p.x = cvt_pk_bf16(wsrc[0], wsrc[64]); p.y = cvt_pk_bf16(wsrc[128], wsrc[192]); p.z = cvt_pk_bf16(wsrc[256], wsrc[320]); p.w = cvt_pk_bf16(wsrc[384], wsrc[448]);
        *(LAS u32x4*)(lds + L_WL + ((gsel * 4 + ct) * 2 + ks) * 1024 + l * 16) = p; }
    if (tid < 320) { const int k = tid >> 6, c = tid & 63; ((LAS float*)(lds + L_CW))[tid] = k < 4 ? A.lcw[k * DL + 64 * uh + c] : A.lcb[64 * uh + c]; }
    if (tid < 64) { const int c = 64 * uh + tid; const float lm = A.lam[c]; const float sp = (-lm > 20.f) ? -lm : log1pf(__expf(-lm));
        *(LAS f32x4*)(lds + L_CST + tid * 16) = (f32x4){-1.44269504f * A.bga[c], -1.44269504f * A.bgx[c], -8.0f * sp * 1.44269504f, -16.0f * sp}; }
}

__global__ void __launch_bounds__(512, 2) mega(Args A) {
    extern __shared__ __attribute__((aligned(16))) unsigned char lds_raw[];
    LAS unsigned char* lds = (LAS unsigned char*)lds_raw;
    unsigned* const bwords = (unsigned*)(A.ws + WS_CTL) + 1024;
    unsigned* const iflag = (unsigned*)(A.ws + WS_CTL); unsigned* const idone = iflag + 64; unsigned* const pcnt = iflag + 8192;
    if (threadIdx.x < 2) ((volatile LAS unsigned*)(lds + L_MISC))[threadIdx.x] = 0u;
    if (blockIdx.x == 0 && threadIdx.x < 64) {
        const int l = threadIdx.x;
        if (l < 16) { __hip_atomic_store(&bwords[XB_XCNT(l)], 0u, __ATOMIC_RELAXED, __HIP_MEMORY_SCOPE_AGENT); __hip_atomic_store(&bwords[XB_XSUB(l)], 0u, __ATOMIC_RELAXED, __HIP_MEMORY_SCOPE_AGENT);
                      __hip_atomic_store(&bwords[XB_XGEN(l)], 0u, __ATOMIC_RELAXED, __HIP_MEMORY_SCOPE_AGENT); }
        if (l == 16) __hip_atomic_store(&bwords[XB_TOP], 0u, __ATOMIC_RELAXED, __HIP_MEMORY_SCOPE_AGENT);
        if (l == 17) __hip_atomic_store(&bwords[XB_TOPGEN], 0u, __ATOMIC_RELAXED, __HIP_MEMORY_SCOPE_AGENT);
        if (l == 18) __hip_atomic_store(&bwords[XB_TMO], 0u, __ATOMIC_RELAXED, __HIP_MEMORY_SCOPE_AGENT);
        if (l == 19) __hip_atomic_store(idone, 0u, __ATOMIC_RELAXED, __HIP_MEMORY_SCOPE_AGENT);
        if (l >= 32) __hip_atomic_store(pcnt + 64 * (l - 32), 0u, __ATOMIC_RELAXED, __HIP_MEMORY_SCOPE_AGENT);
        asm volatile("s_waitcnt vmcnt(0)" ::: "memory");
        __builtin_amdgcn_fence(__ATOMIC_RELEASE, "agent");
        asm volatile("s_waitcnt vmcnt(0)" ::: "memory");
        if (l == 0) __hip_atomic_store(iflag, INIT_TOKEN, __ATOMIC_RELEASE, __HIP_MEMORY_SCOPE_AGENT);
    }
    __syncthreads();
    const int G = gridDim.x, bx = blockIdx.x;
#define PHASE_IDS() int tid = threadIdx.x; asm volatile("" : "+v"(tid)); const int lane = tid & 63, wid = __builtin_amdgcn_readfirstlane(tid >> 6); (void)lane; (void)wid
    unsigned char* ws = A.ws;
    bf16_t* W1T = (bf16_t*)(ws + WS_W1T); bf16_t* W3T = (bf16_t*)(ws + WS_W3T); bf16_t* WPT = (bf16_t*)(ws + WS_WPT);
    bf16_t* HN = (bf16_t*)(ws + WS_HN); bf16_t* Z = (bf16_t*)(ws + WS_Z); bf16_t* VLN = (bf16_t*)(ws + WS_VLN); bf16_t* Y = (bf16_t*)(ws + WS_Y);
    float* PART = (float*)(ws + WS_PART); f32x2* CARRY = (f32x2*)(ws + WS_CARRY); float* HMETA = (float*)(ws + WS_CARRY + 512 * 1024);

    for (int rep = 0; rep <= PROBE_P0; ++rep) {
        PHASE_IDS();
        LAS float* scr = (LAS float*)(lds + wid * 8448);
        const int gw = bx * 8 + wid, NGW = G * 8;
        constexpr int I1 = (DM / 64) * (NIN / 32);
        for (int it = gw; it < I1; it += NGW) p0_transpose_item<true>(A.w_in, DM, NIN, W1T, scr, it, lane);
        for (int m = gw; m < MX + NMETA; m += NGW) {
            u32x2* o8 = (u32x2*)(HN + (size_t)m * DM) + lane;
            if (m >= MX + NMETA) {
#pragma unroll
                for (int j = 0; j < 8; ++j) o8[64 * j] = (u32x2){0u, 0u};
                continue; }
            const float* src = m < MX ? A.x + (size_t)m * DM : A.meta + (size_t)(m - MX) * DM;
            const f32x4* s4 = (const f32x4*)src + lane; f32x4 v[8]; float ss = 0.f;
#pragma unroll
            for (int j = 0; j < 8; ++j) { v[j] = __builtin_nontemporal_load(s4 + 64 * j); ss += (v[j][0] * v[j][0] + v[j][1] * v[j][1]) + (v[j][2] * v[j][2] + v[j][3] * v[j][3]); }
            const float rstd = 1.0f / sqrtf(wave_sum(ss) * (1.0f / DM) + EPS);
            const f32x4* w4 = (const f32x4*)A.pre_w + lane;
#pragma unroll
            for (int j = 0; j < 8; ++j) { const f32x4 w = w4[64 * j]; o8[64 * j] = (u32x2){cvt_pk_bf16(v[j][0] * rstd * w[0], v[j][1] * rstd * w[1]), cvt_pk_bf16(v[j][2] * rstd * w[2], v[j][3] * rstd * w[3])}; }
        }
    }
    if (threadIdx.x == 0) { unsigned sp = 0; while (__hip_atomic_load(iflag, __ATOMIC_RELAXED, __HIP_MEMORY_SCOPE_AGENT) != INIT_TOKEN) { __builtin_amdgcn_s_sleep(2); if (++sp > (1u << 22)) break; }
        __builtin_amdgcn_fence(__ATOMIC_ACQUIRE, "agent"); }
    __syncthreads();
    const XcdBarrier gbar = xcd_barrier_post(bwords, (volatile LAS unsigned*)(lds + L_MISC));
    xcd_barrier(gbar, 1u);

    for (int rep = 0; rep <= PROBE_P1; ++rep) {
        {
            PHASE_IDS();
            const int r = lane & 15, kq = lane >> 4; const int job = bx; const bool glu = job >= 192;
            int n1, n2 = 0;
            if (!glu) n1 = 16 * job < ZC_U1 ? 16 * job : 16 * job + 2048;
            else { const int ch0 = 16 * (job - 192); n1 = ZC_U1 + 256 * (ch0 >> 7) + (ch0 & 127); n2 = n1 + 128; }
            const bf16_t* ap = HN + (size_t)(MX + r) * DM + 8 * kq + 256 * wid;
            const bf16_t* bp1 = W1T + (size_t)(n1 + r) * DM + 8 * kq + 256 * wid; const bf16_t* bp2 = W1T + (size_t)(n2 + r) * DM + 8 * kq + 256 * wid;
            f32x4 c1 = (f32x4){0.f, 0.f, 0.f, 0.f}, c2 = (f32x4){0.f, 0.f, 0.f, 0.f};
            if (job < 256) {
#pragma unroll
                for (int ks = 0; ks < 8; ++ks) { const bf16x8 av = *(const bf16x8*)(ap + 32 * ks); const bf16x8 b1 = *(const bf16x8*)(bp1 + 32 * ks);
                    c1 = __builtin_amdgcn_mfma_f32_16x16x32_bf16(av, b1, c1, 0, 0, 0);
                    if (glu) { const bf16x8 b2 = *(const bf16x8*)(bp2 + 32 * ks); c2 = __builtin_amdgcn_mfma_f32_16x16x32_bf16(av, b2, c2, 0, 0, 0); } }
                LAS f32x4* red = (LAS f32x4*)lds;
                red[(wid * 2 + 0) * 64 + lane] = c1; red[(wid * 2 + 1) * 64 + lane] = c2;
            }
            __syncthreads();
            if (job < 256 && wid == 0) { const LAS f32x4* red = (const LAS f32x4*)lds; f32x4 t1 = red[lane], t2 = red[64 + lane];
#pragma unroll
                for (int w = 1; w < 8; ++w) { t1 += red[(w * 2 + 0) * 64 + lane]; t2 += red[(w * 2 + 1) * 64 + lane]; }
                if (!glu) { const float bb = A.b_in[n1 + r];
#pragma unroll
                    for (int j = 0; j < 4; ++j) Z[(size_t)(MX + 4 * kq + j) * NIN + n1 + r] = (bf16_t)(cvt_pk_bf16(t1[j] + bb, 0.f) & 0xffffu); }
                else { const int ch = 16 * (job - 192) + r; const float b1 = A.b_in[ZC_U1 + ch], b2 = A.b_in[ZC_U2 + ch];
#pragma unroll
                    for (int j = 0; j < 4; ++j) Z[(size_t)(MX + 4 * kq + j) * NIN + ZC_U1 + ch] = (bf16_t)(cvt_pk_bf16((t1[j] + b1) * sigm(t2[j] + b2), 0.f) & 0xffffu); } }
            __syncthreads();
        }
        { pg8::EpiZ E{Z, NIN, A.b_in, 0}; pg8::StaticOrder S; S.init(MX, ZC_GC, G, bx);
          pg8::Gemm g{HN, W1T, MX, ZC_GC, DM}; pg8::gemm_phase<pg8::EpiZ, pg8::StaticOrder, true>(lds, g, S, E); }
    }
    const bool split2 = (2 * (MX / 256) * ((NIN - ZC_GC) / 256) == G) && bx < G / 2;
    if (split2) xcd_barrier_arrive(gbar); else xcd_barrier(gbar, 2u);

    if (2 * (MX / 256) * ((NIN - ZC_GC) / 256) == G) {
        if (bx < G / 2) { pg8::EpiZ E{Z, NIN, A.b_in, ZC_GC / 256}; pg8::StaticOrder S; S.init(MX, NIN - ZC_GC, G / 2, bx);
            pg8::Gemm g{HN, W1T + (size_t)ZC_GC * DM, MX, NIN - ZC_GC, DM}; pg8::gemm_phase<pg8::EpiZ, pg8::StaticOrder, true>(lds, g, S, E);
            xcd_barrier_wait(gbar, 2u); }
        else { { const int j = bx - G / 2, t = (j & 7) * (G / 16) + (j >> 3);
                 for (int ti = t; ti < MX / 32; ti += G / 2) conf_tile(A, Z, VLN, lds, ti); }
            if (bx - G / 2 < 16) { PHASE_IDS(); const int mh = bx - G / 2;
                lru_fill_tables(A, mh, lds, tid);
                __syncthreads();
                if (wid == 0) { float cP[4] = {1.f, 1.f, 1.f, 1.f}, cH[4] = {0.f, 0.f, 0.f, 0.f}; float dH[4][4], dP[4][4];
                    lru_mtile<false, false>(Z, 0, mh, 0, lds, lds, lds + L_XT, lane, cP, cH, dH, dP);
                    if (lane < 16) {
#pragma unroll
                        for (int ct = 0; ct < 4; ++ct) HMETA[mh * 64 + 16 * ct + lane] = cH[ct]; } }
                __syncthreads(); }
            else { PHASE_IDS();
                LAS float* scr = (LAS float*)(lds + wid * 8448);
                const int gw = (bx - G / 2 - 16) * 8 + wid, NGW = (G / 2 - 16) * 8;
                constexpr int I3 = (DM / 64) * (DM / 32), IP = (DC / 64) * (DC / 32);
                for (int it = gw; it < I3 + IP; it += NGW) { if (it < I3) p0_transpose_item<false>(A.w_out, DM, DM, W3T, scr, it, lane); else p0_transpose_item<false>(A.cpw, DC, DC, WPT, scr, it - I3, lane); } } }
    } else {
        { pg8::EpiZ E{Z, NIN, A.b_in, ZC_GC / 256}; pg8::StaticOrder S; S.init(MX, NIN - ZC_GC, G, bx);
          pg8::Gemm g{HN, W1T + (size_t)ZC_GC * DM, MX, NIN - ZC_GC, DM}; pg8::gemm_phase<pg8::EpiZ, pg8::StaticOrder, true>(lds, g, S, E); }
        for (int ti = bx; ti < MX / 32; ti += G) conf_tile(A, Z, VLN, lds, ti);
    }
    __syncthreads();

    const int ub = bx >> 6, uh = (bx >> 2) & 15, uq = bx & 3;
    float sH[4][4][4], sP[4][4][4];
    for (int rep = 0; rep <= PROBE_P2B; ++rep) {
        if (rep) __syncthreads();
        PHASE_IDS();
        { u32x4 tv[9];
#pragma unroll
          for (int it = 0; it < 9; ++it) { const int idx = tid + 512 * it; const int row = idx >> 3, c = idx & 7; tv[it] = (u32x4){0u, 0u, 0u, 0u};
              if (idx < XS_ROWS * 8) tv[it] = *(const u32x4*)(zrow(Z, ub, NMETA + 512 * uq - 3 + row) + ZC_XL + 64 * uh + 8 * c); }
#pragma unroll
          for (int it = 0; it < 9; ++it) { const int idx = tid + 512 * it; const int row = idx >> 3, c = idx & 7;
              if (idx < XS_ROWS * 8) *(LAS u32x4*)(lds + L_XS + row * XS_STRIDE + c * 16) = tv[it]; } }
        lru_fill_tables(A, uh, lds, tid);
        __syncthreads();
        LAS unsigned char* xt = lds + L_XT + wid * XT_BYTES;
        float cP[4] = {1.f, 1.f, 1.f, 1.f}, cH[4] = {0.f, 0.f, 0.f, 0.f};
        const int hb0 = NMETA + 512 * uq + 64 * wid;
#pragma unroll
        for (int mt = 0; mt < 4; ++mt) lru_mtile<true, true>(Z, ub, uh, hb0 + 16 * mt, lds + L_XS + (64 * wid + 16 * mt) * XS_STRIDE, lds, xt, lane, cP, cH, sH[mt], sP[mt]);
        LAS f32x2* wt = (LAS f32x2*)(lds + L_WT);
        if (lane < 16) {
#pragma unroll
            for (int ct = 0; ct < 4; ++ct) wt[wid * 64 + 16 * ct + lane] = (f32x2){cP[ct], cH[ct]}; }
        __syncthreads();
        if (tid < 64) { float P = 1.f, H = 0.f;
#pragma unroll
            for (int w = 0; w < 8; ++w) { const f32x2 t = wt[w * 64 + tid]; H = H * t.x + t.y; P = P * t.x; }
            CARRY[((ub * 16 + uh) * 4 + uq) * 64 + tid] = (f32x2){P, H}; }
    }
    xcd_barrier_arrive(gbar);
    u32x4 gq[8];
    { const int lane_ = threadIdx.x & 63, wid_ = threadIdx.x >> 6;
#pragma unroll
      for (int i = 0; i < 8; ++i) { const int piece = lane_ + 64 * i, tl = piece >> 3, c8 = piece & 7; const size_t row = (size_t)ub * SEQ + 512 * uq + 64 * wid_ + tl;
          gq[i] = *(const u32x4*)(Z + row * NIN + ZC_GL + 64 * uh + 8 * c8); } }
    xcd_barrier_wait(gbar, 3u);

    {
        PHASE_IDS();
        const LAS f32x2* wt = (const LAS f32x2*)(lds + L_WT);
        LAS unsigned char* yt = lds + L_YT + wid * YT_BYTES;
        const int r = lane & 15, kq = lane >> 4;
#pragma unroll
        for (int ct = 0; ct < 4; ++ct) { const int c = 16 * ct + r; float hin = HMETA[uh * 64 + c];
            for (int q = 0; q < uq; ++q) { const f32x2 t = CARRY[((ub * 16 + uh) * 4 + q) * 64 + c]; hin = hin * t.x + t.y; }
            for (int w = 0; w < wid; ++w) { const f32x2 t = wt[w * 64 + c]; hin = hin * t.x + t.y; }
#pragma unroll
            for (int mt = 0; mt < 4; ++mt)
#pragma unroll
                for (int j = 0; j < 4; ++j) { const float hv = sH[mt][ct][j] + sP[mt][ct][j] * hin;
                    *(LAS unsigned short*)(yt + (16 * mt + 4 * kq + j) * YT_STRIDE + c * 2) = (unsigned short)(cvt_pk_bf16(hv, 0.f) & 0xffffu); } }
        asm volatile("s_waitcnt lgkmcnt(0)" ::: "memory");
        __builtin_amdgcn_wave_barrier();
#pragma unroll
        for (int i = 0; i < 8; ++i) { const int piece = lane + 64 * i, tl = piece >> 3, c8 = piece & 7;
            const u32x4 hv = *(const LAS u32x4*)(yt + tl * YT_STRIDE + c8 * 16);
            const size_t row = (size_t)ub * SEQ + 512 * uq + 64 * wid + tl;
            const u32x4 g = gq[i];
            u32x4 o;
            o.x = cvt_pk_bf16(bf_lo(hv.x) * siluf(bf_lo(g.x)), bf_hi(hv.x) * siluf(bf_hi(g.x)));
            o.y = cvt_pk_bf16(bf_lo(hv.y) * siluf(bf_lo(g.y)), bf_hi(hv.y) * siluf(bf_hi(g.y)));
            o.z = cvt_pk_bf16(bf_lo(hv.z) * siluf(bf_lo(g.z)), bf_hi(hv.z) * siluf(bf_hi(g.z)));
            o.w = cvt_pk_bf16(bf_lo(hv.w) * siluf(bf_lo(g.w)), bf_hi(hv.w) * siluf(bf_hi(g.w)));
            *(u32x4*)(Y + row * DM + 64 * uh + 8 * c8) = o; }
    }
    __syncthreads();

    for (int rep = 0; rep <= PROBE_P3; ++rep) {
        pg8::EpiPW E{Y, Z, A.cpb};
        pg8::StaticOrder S; S.init(MX, DC, G, bx);
        if (2 * S.nwg == G) { pg8::Unit u; S.at((bx & 7) + 8 * (bx >> 4), u); const int rowbase = u.pm * 256 + 128 * ((bx >> 3) & 1);
            pg8::gemm_half_phase<pg8::EpiPW>(lds, VLN + (size_t)rowbase * DC, WPT + (size_t)u.pn * 256 * DC, DC, rowbase, u.pn, E); }
        else { pg8::Gemm g{VLN, WPT, MX, DC, DC}; pg8::gemm_phase<pg8::EpiPW, pg8::StaticOrder, true>(lds, g, S, E); }
    }
    xcd_barrier(gbar, 4u);

    {
        pg8::Gemm g{Y, W3T, MX, DM, DM}; pg8::StaticOrder S; S.init(MX, DM, G, bx);
        pg8::EpiOut E{A.x, A.out, A.post_w, PART, pcnt};
        pg8::gemm_phase<pg8::EpiOut, pg8::StaticOrder, false>(lds, g, S, E);
    }
    __syncthreads();
    if (threadIdx.x == 0) { const unsigned old = __hip_atomic_fetch_add(idone, 1u, __ATOMIC_RELAXED, __HIP_MEMORY_SCOPE_AGENT); if (old + 1u == (unsigned)G) __hip_atomic_store(iflag, 0u, __ATOMIC_RELAXED, __HIP_MEMORY_SCOPE_AGENT); }
}

extern "C" void kernel_launch(void* const* d_in, const int* in_sizes, int n_in, void* d_out, int out_size, void* d_ws, size_t ws_size, hipStream_t stream) {
    static int grid = 0;
    if (grid == 0) {
        if (n_in != 20 || out_size != MX * DM || ws_size < WS_END) { fprintf(stderr, "kernel_launch: unexpected problem shape (n_in %d out %d ws %zu)\n", n_in, out_size, ws_size); grid = -1; return; }
        int dev = 0, cus = 0, per_cu = 0;
        hipGetDevice(&dev); hipDeviceGetAttribute(&cus, hipDeviceAttributeMultiprocessorCount, dev);
        if (hipFuncSetAttribute((const void*)mega, hipFuncAttributeMaxDynamicSharedMemorySize, LDS_BYTES) != hipSuccess) { fprintf(stderr, "kernel_launch: hipFuncSetAttribute failed\n"); grid = -1; return; }
        hipOccupancyMaxActiveBlocksPerMultiprocessor(&per_cu, (const void*)mega, 512, LDS_BYTES);
        if (cus * per_cu < 256) { fprintf(stderr, "kernel_launch: need 256 resident workgroups, device offers %d x %d\n", cus, per_cu); grid = -1; return; }
        grid = 256;
    }
    if (grid < 0) return;
    Args a{};
    const float** ap = (const float**)&a;
    for (int i = 0; i < 20; ++i) ap[i] = (const float*)d_in[i];
    a.out = (float*)d_out; a.ws = (unsigned char*)d_ws;
    void* args[] = {&a};
    hipError_t e = hipLaunchCooperativeKernel((const void*)mega, dim3(grid), dim3(512), args, LDS_BYTES, stream);
    if (e != hipSuccess) fprintf(stderr, "cooperative launch failed: %s\n", hipGetErrorString(e));
}
```

```cpp
#include <hip/hip_runtime.h>
#include <cstdio>
#include <cstdint>
#include <utility>

#define LAS __attribute__((address_space(3)))
typedef unsigned short bf16_t;
typedef short bf16x8 __attribute__((ext_vector_type(8)));
typedef float f32x4 __attribute__((ext_vector_type(4)));
typedef float f32x2 __attribute__((ext_vector_type(2)));
typedef unsigned u32x4 __attribute__((ext_vector_type(4)));
typedef unsigned u32x2 __attribute__((ext_vector_type(2)));

constexpr int DM = 2048, NBATCH = 4, SEQ = 2048, NMETA = 16, MX = NBATCH * SEQ  , MPAD = MX + 256  , NIN = 5120, DL = 1024, DC = 1024;
constexpr int ZC_XL = 0, ZC_GL = 1024, ZC_U1 = 2048, ZC_U2 = 3072, ZC_GC = 4096;
constexpr float EPS = 1e-6f;
constexpr size_t MiB = 1u << 20;
constexpr size_t WS_W1T = 1 * MiB;
constexpr size_t WS_W3T = 22 * MiB;
constexpr size_t WS_WPT = 30 * MiB;
constexpr size_t WS_HN = 32 * MiB;
constexpr size_t WS_Z = 66 * MiB;
constexpr size_t WS_VLN = 150 * MiB;
constexpr size_t WS_Y = 166 * MiB;
constexpr size_t WS_PART = 198 * MiB;
constexpr size_t WS_CARRY = 199 * MiB;
constexpr size_t WS_END = 200 * MiB;
static_assert(WS_W1T + (size_t)NIN * DM * 2 <= WS_W3T && WS_HN + (size_t)MPAD * DM * 2 <= WS_Z && WS_Z + (size_t)MPAD * NIN * 2 <= WS_VLN, "ws map");
constexpr int LDS_BYTES = 149504, L_MISC = 148480;
constexpr size_t WS_CTL = 0, CTL_BYTES = 32768;
constexpr unsigned INIT_TOKEN = 0x5EEDC0DEu;
constexpr int PROBE_SYNC = 0, PROBE_P0 = 0, PROBE_P1 = 0, PROBE_P2B = 0, PROBE_P3 = 0;

__device__ __forceinline__ unsigned cvt_pk_bf16(float lo, float hi) { unsigned r; asm volatile("v_cvt_pk_bf16_f32 %0, %1, %2" : "=v"(r) : "v"(lo), "v"(hi)); return r; }
__device__ __forceinline__ float bf_lo(unsigned w) { return __uint_as_float(w << 16); }
__device__ __forceinline__ float bf_hi(unsigned w) { return __uint_as_float(w & 0xffff0000u); }
__device__ __forceinline__ float sigm(float x) { return __builtin_amdgcn_rcpf(1.0f + __expf(-x)); }
__device__ __forceinline__ float siluf(float x) { return x * sigm(x); }


#define XB_TMO      128
#define XB_XCNT(j)  (256  + 64 * (j))
#define XB_XSUB(j)  (1280 + 64 * (j))
#define XB_XGEN(j)  (2304 + 64 * (j))
#define XB_TOP      3328
#define XB_TOPGEN   3392
#define XCD_BAR_WORDS 3456
#define XB_SPIN_CAP (1u << 18)
__device__ __forceinline__ unsigned xb_ld(unsigned* p)              { return __hip_atomic_load(p, __ATOMIC_RELAXED, __HIP_MEMORY_SCOPE_AGENT); }
__device__ __forceinline__ unsigned xb_add(unsigned* p, unsigned v) { return __hip_atomic_fetch_add(p, v, __ATOMIC_RELAXED, __HIP_MEMORY_SCOPE_AGENT); }
__device__ __forceinline__ unsigned xb_xcc_id() { return (unsigned)__builtin_amdgcn_s_getreg((3 << 11) | 20) & 0xFu; }
#define XB_SPIN(cond, bar) do { unsigned _sp = 0; while (cond) { __builtin_amdgcn_s_sleep(1); \
    if ((++_sp & 255u) == 0u) { if (xb_ld(&(bar)[XB_TMO])) break; if (_sp > XB_SPIN_CAP) { atomicAdd(&(bar)[XB_TMO], 1u); break; } } } } while (0)
struct XcdBarrier { unsigned* bar; unsigned x; volatile LAS unsigned* st; };
__device__ __forceinline__ XcdBarrier xcd_barrier_post(unsigned* bar, volatile LAS unsigned* st) {
    XcdBarrier b; b.bar = bar; b.x = xb_xcc_id(); b.st = st;
    if (threadIdx.x == 0) (void)xb_add(&bar[XB_XCNT(b.x)], 1u);
    return b;
}
__device__ __forceinline__ void xcd_barrier_complete(unsigned* bar, unsigned x, unsigned& nloc, unsigned& nx) {
    const unsigned G = gridDim.x * gridDim.y * gridDim.z;
    unsigned sum, cnt, mine, sp = 0u;
    for (;;) {
        sum = 0u; cnt = 0u; mine = 0u;
#pragma unroll
        for (unsigned j = 0; j < 16; ++j) { const unsigned c = xb_ld(&bar[XB_XCNT(j)]); sum += c; cnt += (c > 0u) ? 1u : 0u; mine = (j == x) ? c : mine; }
        if (sum == G) break;
        __builtin_amdgcn_s_sleep(1);
        if ((++sp & 255u) == 0u) { if (xb_ld(&bar[XB_TMO])) break; if (sp > XB_SPIN_CAP) { atomicAdd(&bar[XB_TMO], 1u); break; } }
    }
    nloc = mine > 0u ? mine : 1u; nx = cnt > 0u ? cnt : 1u;
}
__device__ __forceinline__ void xcd_barrier_arrive(const XcdBarrier& b) {
    asm volatile("s_waitcnt vmcnt(0)" ::: "memory");
    __syncthreads();
    if (threadIdx.x == 0) {
        unsigned* bar = b.bar;
        __builtin_amdgcn_s_waitcnt(0);
        unsigned nloc = b.st[0], nx = b.st[1];
        if (nloc == 0u) { xcd_barrier_complete(bar, b.x, nloc, nx); b.st[0] = nloc; b.st[1] = nx; }
        const unsigned old = xb_add(&bar[XB_XSUB(b.x)], 1u);
        const unsigned gen = old / nloc;
        if (old + 1u == (gen + 1u) * nloc) {
            __builtin_amdgcn_fence(__ATOMIC_RELEASE, "agent");
            asm volatile("s_waitcnt vmcnt(0)" ::: "memory");
            const unsigned og = xb_add(&bar[XB_TOP], 1u);
            const unsigned tg = og / nx;
            if (og + 1u == (tg + 1u) * nx) {
#pragma unroll
                for (int j = 0; j < 16; ++j) (void)__hip_atomic_fetch_add(&bar[XB_XGEN(j)], 1u, __ATOMIC_RELAXED, __HIP_MEMORY_SCOPE_AGENT);
            }
        }
    }
}
__device__ __forceinline__ void xcd_barrier_wait(const XcdBarrier& b, unsigned k) {
    if (threadIdx.x == 0) {
        unsigned* bar = b.bar;
        XB_SPIN((int)(xb_ld(&bar[XB_XGEN(b.x)]) - k) < 0, bar);
        __builtin_amdgcn_fence(__ATOMIC_ACQUIRE, "agent");
        asm volatile("s_waitcnt vmcnt(0)" ::: "memory");
    }
    __syncthreads();
}
__device__ __forceinline__ void xcd_barrier(const XcdBarrier& b, unsigned k) { xcd_barrier_arrive(b); xcd_barrier_wait(b, k); }

namespace pg8 {
#define PG8_LAS __attribute__((address_space(3)))
constexpr int BM = 256, BK = 64, HALF = 128, HTB = HALF * BK * 2, STAGE_BYTES = 8 * HTB, NXCD = 8, WGM = 8;
__host__ __device__ __forceinline__ int lds_byte(int r, int c) { const int st = (r >> 4) * 2 + (c >> 5), rr = r & 15, cc = c & 31, ob = rr * 64 + cc * 2; return st * 1024 + (ob ^ (((ob >> 9) & 1) << 5)); }
__host__ __device__ __forceinline__ void stage_rc(int b, int& R, int& C) { const int st = b / 1024, sb = b % 1024, swz = sb ^ (((sb >> 9) & 1) << 5); R = (st >> 1) * 16 + swz / 64; C = (st & 1) * 32 + (swz % 64) / 2; }
__host__ __device__ __forceinline__ int perm32(int rho) { const int n = rho >> 4, i = rho & 15; return 8 * (i >> 2) + 4 * n + (i & 3); }
struct Unit { int pm, pn; };
struct Gemm { const bf16_t* A; const bf16_t* Bt; int M, N, K; };
struct StaticOrder {
    int nM, nN, nwg, G, c, nlim;
    __host__ __device__ void init(int M, int N, int G_, int c_) { nM = M / BM; nN = N / BM; nwg = nM * nN; G = G_; c = c_; nlim = nwg; }
    __host__ __device__ bool at(long L, Unit& u) const {
        int wgid = (int)L; { const int q = nwg / NXCD, r = nwg % NXCD, xcd = wgid % NXCD, off = wgid / NXCD; wgid = (xcd < r ? xcd * (q + 1) : r * (q + 1) + (xcd - r) * q) + off; }
        const int nig = WGM * nN, gid = wgid / nig, fm = gid * WGM, gsz = (nM - fm) < WGM ? (nM - fm) : WGM;
        u.pm = fm + ((wgid % nig) % gsz); u.pn = (wgid % nig) / gsz; return true;
    }
    __host__ __device__ bool next(int i, Unit& u) const { const long L = (long)i * G + c; if (L >= nlim) return false; return at(L, u); }
    __device__ __forceinline__ void a_ready(const Unit&) const {}
    __device__ __forceinline__ void done(const Unit&) const {}
};
struct EpiZ {
    static constexpr bool PERM = true, AFTER_DRAIN = false;
    bf16_t* O; int ldc; const float* bias; int pn_off;
    template <int NAI> __device__ __forceinline__ void run(const f32x4 (&acc)[NAI][2][4][2], int rowbase, int pn_, int wr, int wc, int fr, int fq) const {
        const int row0 = rowbase + wr * 64 + fr; const int pn = pn_ + pn_off;
        const bool glu = (pn >= 8 && pn < 16);
        const int cin = wc * 32 + 8 * fq;
        const int bc0 = glu ? ZC_U1 + 128 * (pn - 8) + cin : pn * BM + cin;
        const int bc1 = glu ? ZC_U2 + 128 * (pn - 8) + cin : pn * BM + HALF + cin;
        f32x4 bv[2][2];
#pragma unroll
        for (int n = 0; n < 2; ++n) { bv[0][n] = *(const f32x4*)(bias + bc0 + 4 * n); bv[1][n] = *(const f32x4*)(bias + bc1 + 4 * n); }
        if (glu) {
#pragma unroll
            for (int ai = 0; ai < NAI; ++ai)
#pragma unroll
                for (int m = 0; m < 4; ++m) { bf16_t* rowp = O + (size_t)(row0 + ai * HALF + m * 16) * ldc + bc0;
                    const f32x4 a0 = acc[ai][0][m][0] + bv[0][0], a1 = acc[ai][0][m][1] + bv[0][1], g0 = acc[ai][1][m][0] + bv[1][0], g1 = acc[ai][1][m][1] + bv[1][1];
                    u32x4 w; w.x = cvt_pk_bf16(a0[0] * sigm(g0[0]), a0[1] * sigm(g0[1])); w.y = cvt_pk_bf16(a0[2] * sigm(g0[2]), a0[3] * sigm(g0[3]));
                    w.z = cvt_pk_bf16(a1[0] * sigm(g1[0]), a1[1] * sigm(g1[1])); w.w = cvt_pk_bf16(a1[2] * sigm(g1[2]), a1[3] * sigm(g1[3]));
                    *(u32x4*)rowp = w; }
        } else {
#pragma unroll
            for (int ai = 0; ai < NAI; ++ai)
#pragma unroll
                for (int m = 0; m < 4; ++m) { bf16_t* rowp = O + (size_t)(row0 + ai * HALF + m * 16) * ldc + bc0;
#pragma unroll
                    for (int bj = 0; bj < 2; ++bj) { const f32x4 v0 = acc[ai][bj][m][0] + bv[bj][0], v1 = acc[ai][bj][m][1] + bv[bj][1];
                        u32x4 w; w.x = cvt_pk_bf16(v0[0], v0[1]); w.y = cvt_pk_bf16(v0[2], v0[3]); w.z = cvt_pk_bf16(v1[0], v1[1]); w.w = cvt_pk_bf16(v1[2], v1[3]);
                        *(u32x4*)(rowp + bj * HALF) = w; } }
        }
    }
};
struct EpiPW {
    static constexpr bool PERM = true, AFTER_DRAIN = false;
    bf16_t* Y; const bf16_t* Z; const float* bias;
    template <int NAI> __device__ __forceinline__ void run(const f32x4 (&acc)[NAI][2][4][2], int rowbase, int pn, int wr, int wc, int fr, int fq) const {
        const int row0 = rowbase + wr * 64 + fr; const int col0 = pn * BM + wc * 32 + 8 * fq;
        f32x4 bv[2][2];
#pragma unroll
        for (int bj = 0; bj < 2; ++bj)
#pragma unroll
            for (int n = 0; n < 2; ++n) bv[bj][n] = *(const f32x4*)(bias + col0 + bj * HALF + 4 * n);
#pragma unroll
        for (int ai = 0; ai < NAI; ++ai)
#pragma unroll
            for (int m = 0; m < 4; ++m) { const size_t row = (size_t)(row0 + ai * HALF + m * 16);
#pragma unroll
                for (int bj = 0; bj < 2; ++bj) { const f32x4 v0 = acc[ai][bj][m][0] + bv[bj][0], v1 = acc[ai][bj][m][1] + bv[bj][1];
                    const u32x4 g = *(const u32x4*)(Z + row * NIN + ZC_GC + col0 + bj * HALF);
                    u32x4 w;
                    w.x = cvt_pk_bf16(v0[0] * siluf(bf_lo(g.x)), v0[1] * siluf(bf_hi(g.x)));
                    w.y = cvt_pk_bf16(v0[2] * siluf(bf_lo(g.y)), v0[3] * siluf(bf_hi(g.y)));
                    w.z = cvt_pk_bf16(v1[0] * siluf(bf_lo(g.z)), v1[1] * siluf(bf_hi(g.z)));
                    w.w = cvt_pk_bf16(v1[2] * siluf(bf_lo(g.w)), v1[3] * siluf(bf_hi(g.w)));
                    *(u32x4*)(Y + row * DM + DL + col0 + bj * HALF) = w; } }
    }
};
struct EpiOut {
    static constexpr bool PERM = false, AFTER_DRAIN = true;
    const float* x; float* out; const float* pw; float* part; unsigned* cnt;
    __device__ __forceinline__ void fused(f32x4 (&acc)[2][2][4][2], const Unit& u, int wr, int wc, int fr, int fq, PG8_LAS unsigned char* lds, int wid, int lane) const {
        PG8_LAS float* P = (PG8_LAS float*)lds;
        PG8_LAS float* S = (PG8_LAS float*)(lds + 8192);
#pragma unroll
        for (int ai = 0; ai < 2; ++ai)
#pragma unroll
            for (int m = 0; m < 4; ++m) { float s = 0.f;
#pragma unroll
                for (int bj = 0; bj < 2; ++bj)
#pragma unroll
                    for (int n = 0; n < 2; ++n) { const f32x4 v = acc[ai][bj][m][n]; s += (v[0] * v[0] + v[1] * v[1]) + (v[2] * v[2] + v[3] * v[3]); }
                s += __shfl_xor(s, 16); s += __shfl_xor(s, 32);
                if (fq == 0) P[(ai * HALF + wr * 64 + m * 16 + fr) * 4 + wc] = s; }
        __syncthreads();
        const int tid = wid * 64 + lane;
        if (tid < 256) { const float t = (P[tid * 4 + 0] + P[tid * 4 + 1]) + (P[tid * 4 + 2] + P[tid * 4 + 3]); __hip_atomic_store(part + (size_t)(u.pm * BM + tid) * 8 + u.pn, t, __ATOMIC_RELAXED, __HIP_MEMORY_SCOPE_AGENT);
            asm volatile("s_waitcnt vmcnt(0)" ::: "memory");
            if (lane == 0) __hip_atomic_fetch_add(cnt + 64 * u.pm, 1u, __ATOMIC_RELAXED, __HIP_MEMORY_SCOPE_AGENT); }
        PG8_LAS float* T = (PG8_LAS float*)(lds + 9216);
        constexpr int TS = 260;
        const size_t gbase = (size_t)(u.pm * BM) * DM + (size_t)u.pn * BM + 4 * lane;
        f32x4 xr[16];
#pragma unroll
        for (int rr = 0; rr < 16; ++rr) xr[rr] = __builtin_nontemporal_load((const f32x4*)(x + gbase + (size_t)(wid * 16 + rr) * DM));
        if (wid == 0) {
            unsigned sp = 0;
            while ((unsigned)__builtin_amdgcn_readfirstlane(__hip_atomic_load(cnt + 64 * u.pm, __ATOMIC_RELAXED, __HIP_MEMORY_SCOPE_AGENT)) < 32u) { __builtin_amdgcn_s_sleep(2); if (++sp > (1u << 22)) break; }
            __builtin_amdgcn_fence(__ATOMIC_ACQUIRE, "agent");
            asm volatile("s_waitcnt vmcnt(0)" ::: "memory");
        }
        __syncthreads();
        if (tid < 256) { const float* pp = part + (size_t)(u.pm * BM + tid) * 8; float t = 0.f;
#pragma unroll
            for (int k = 0; k < 8; ++k) t += __hip_atomic_load(pp + k, __ATOMIC_RELAXED, __HIP_MEMORY_SCOPE_AGENT);
            S[tid] = 1.0f / sqrtf(t * (1.0f / (float)DM) + EPS); }
        const f32x4 wv = *(const f32x4*)(pw + u.pn * BM + 4 * lane);
        f32x4 xr2[16];
#pragma unroll
        for (int ai = 0; ai < 2; ++ai) {
            if (ai == 1) __syncthreads();
#pragma unroll
            for (int m = 0; m < 4; ++m)
#pragma unroll
                for (int bj = 0; bj < 2; ++bj)
#pragma unroll
                    for (int n = 0; n < 2; ++n) *(PG8_LAS f32x4*)(T + (wr * 64 + m * 16 + fr) * TS + bj * HALF + wc * 32 + n * 16 + 4 * fq) = acc[ai][bj][m][n];
            if (ai == 0) {
#pragma unroll
                for (int rr = 0; rr < 16; ++rr) xr2[rr] = __builtin_nontemporal_load((const f32x4*)(x + gbase + (size_t)(HALF + wid * 16 + rr) * DM));
            }
            __syncthreads();
#pragma unroll
            for (int rr = 0; rr < 16; ++rr) { const int rl = wid * 16 + rr; const float rs = S[ai * HALF + rl];
                const f32x4 y = *(const PG8_LAS f32x4*)(T + rl * TS + 4 * lane);
                const f32x4 o = (ai == 0 ? xr[rr] : xr2[rr]) + y * rs * wv;
                __builtin_nontemporal_store(o, (f32x4*)(out + gbase + (size_t)(ai * HALF + rl) * DM)); }
        }
    }
};

template <class Epi, class Sched, bool ALIGN_EPI = false>
__device__ __forceinline__ void gemm_phase(PG8_LAS unsigned char* lds, const Gemm g, const Sched& S, const Epi& E) {
    int tid = threadIdx.x; asm volatile("" : "+v"(tid));
    const int wid = __builtin_amdgcn_readfirstlane(tid >> 6), lane = tid & 63, wr = wid >> 2, wc = wid & 3, fr = lane & 15, fq = lane >> 4;
    const int K = g.K, nt = K / BK;
    unsigned voffA[2], voffB[2];
#pragma unroll
    for (int i = 0; i < 2; ++i) { int R, C; stage_rc(tid * 16 + i * 8192, R, C); const int Rb = Epi::PERM ? ((R & ~31) + perm32(R & 31)) : R;
        voffA[i] = (unsigned)(R * K + C) * 2u; voffB[i] = (unsigned)(Rb * K + C) * 2u; }
    const size_t kstep = (size_t)(BK * 2);
    const size_t hstep = (size_t)HALF * K * 2;
    const size_t tstep = 2 * hstep;
    const unsigned ldsw = (unsigned)wid * 1024u;
    const int aoff = lds_byte(wr * 64 + fr, fq * 8), boff = lds_byte(wc * 32 + fr, fq * 8);
#define PG8_SA(b, h) (((b) * 2 + (h)) * HTB)
#define PG8_SB(b, h) ((4 + (b) * 2 + (h)) * HTB)
#define PG8_STAGE(bufoff, gbase, voff) do { _Pragma("unroll") for (int _i = 0; _i < 2; ++_i) \
        __builtin_amdgcn_global_load_lds((const unsigned*)((const char*)(gbase) + (voff)[_i]), (PG8_LAS unsigned*)(lds + (bufoff) + ldsw + _i * 8192), 16, 0, 0); } while (0)
#define PG8_LDA(dst, b, h) do { _Pragma("unroll") for (int m = 0; m < 4; ++m) _Pragma("unroll") for (int k = 0; k < 2; ++k) dst[m][k] = *(const PG8_LAS bf16x8*)(lds + PG8_SA(b, h) + aoff + m * 2048 + k * 1024); } while (0)
#define PG8_LDB(dst, b, h) do { _Pragma("unroll") for (int n = 0; n < 2; ++n) _Pragma("unroll") for (int k = 0; k < 2; ++k) dst[n][k] = *(const PG8_LAS bf16x8*)(lds + PG8_SB(b, h) + boff + n * 2048 + k * 1024); } while (0)
#define PG8_MMA(ai, bj, At, Bt) do { __builtin_amdgcn_s_setprio(1); _Pragma("unroll") for (int m = 0; m < 4; ++m) _Pragma("unroll") for (int n = 0; n < 2; ++n) _Pragma("unroll") for (int k = 0; k < 2; ++k) \
        acc[ai][bj][m][n] = __builtin_amdgcn_mfma_f32_16x16x32_bf16(Bt[n][k], At[m][k], acc[ai][bj][m][n], 0, 0, 0); __builtin_amdgcn_s_setprio(0); } while (0)
#define PG8_WAIT_V(n) asm volatile("s_waitcnt vmcnt(" #n ")" ::: "memory")
#define PG8_WAIT_L(n) asm volatile("s_waitcnt lgkmcnt(" #n ")" ::: "memory")
#define PG8_BAR __builtin_amdgcn_s_barrier()
#define PG8_SCHED __builtin_amdgcn_sched_barrier(0)
    Unit cur, nxt; int ui = 0;
    if (!S.next(0, cur)) return;
    f32x4 acc[2][2][4][2];
#pragma unroll
    for (int a = 0; a < 2; ++a)
#pragma unroll
        for (int b = 0; b < 2; ++b)
#pragma unroll
            for (int m = 0; m < 4; ++m)
#pragma unroll
                for (int n = 0; n < 2; ++n) acc[a][b][m][n] = (f32x4){0.f, 0.f, 0.f, 0.f};
    bf16x8 At[4][2], B0[2][2], B1[2][2];
    const char* cA = (const char*)g.A + (size_t)cur.pm * tstep; const char* cB = (const char*)g.Bt + (size_t)cur.pn * tstep;
    S.a_ready(cur);
    PG8_STAGE(PG8_SB(0, 0), cB, voffB); PG8_STAGE(PG8_SB(0, 1), cB + hstep, voffB); PG8_STAGE(PG8_SA(0, 0), cA, voffA); PG8_STAGE(PG8_SA(0, 1), cA + hstep, voffA);
    if (wr == 1) PG8_BAR;
    PG8_WAIT_V(2); PG8_BAR;
    PG8_STAGE(PG8_SB(1, 0), cB + kstep, voffB); PG8_STAGE(PG8_SA(1, 0), cA + kstep, voffA); PG8_STAGE(PG8_SB(1, 1), cB + hstep + kstep, voffB);
    PG8_WAIT_V(6); PG8_BAR;
    for (;;) {
        const bool has_next = S.next(ui + 1, nxt);
        const char* nA = has_next ? (const char*)g.A + (size_t)nxt.pm * tstep : cA; const char* nB = has_next ? (const char*)g.Bt + (size_t)nxt.pn * tstep : cB;
        for (int t = 0; t < nt; t += 2) {
            const bool last = (t == nt - 2);
            const char* a1 = cA + (size_t)(t + 1) * kstep;
            const char* a2 = last ? nA : cA + (size_t)(t + 2) * kstep; const char* b2 = last ? nB : cB + (size_t)(t + 2) * kstep;
            const char* a3 = a2 + kstep; const char* b3 = b2 + kstep;
            if (last && has_next) S.a_ready(nxt);
            PG8_LDB(B0, 0, 0); PG8_LDB(B1, 0, 1); PG8_SCHED; PG8_LDA(At, 0, 0); PG8_STAGE(PG8_SA(1, 1), a1 + hstep, voffA);
            PG8_WAIT_V(8); PG8_WAIT_L(0); PG8_BAR; PG8_MMA(0, 0, At, B0); PG8_MMA(0, 1, At, B1); PG8_BAR; PG8_SCHED;
            PG8_LDA(At, 0, 1); PG8_STAGE(PG8_SB(0, 0), b2, voffB); PG8_STAGE(PG8_SB(0, 1), b2 + hstep, voffB); PG8_STAGE(PG8_SA(0, 0), a2, voffA);
            PG8_WAIT_V(8); PG8_WAIT_L(0); PG8_BAR; PG8_MMA(1, 0, At, B0); PG8_MMA(1, 1, At, B1); PG8_BAR; PG8_SCHED;
            PG8_LDB(B0, 1, 0); PG8_LDB(B1, 1, 1); PG8_SCHED; PG8_LDA(At, 1, 0); PG8_STAGE(PG8_SA(0, 1), a2 + hstep, voffA);
            PG8_WAIT_V(8); PG8_WAIT_L(0); PG8_BAR; PG8_MMA(0, 0, At, B0); PG8_MMA(0, 1, At, B1); PG8_BAR; PG8_SCHED;
            PG8_LDA(At, 1, 1); PG8_STAGE(PG8_SB(1, 0), b3, voffB); PG8_STAGE(PG8_SB(1, 1), b3 + hstep, voffB); PG8_STAGE(PG8_SA(1, 0), a3, voffA);
            PG8_WAIT_V(8); PG8_WAIT_L(0); PG8_BAR; PG8_MMA(1, 0, At, B0); PG8_MMA(1, 1, At, B1); PG8_BAR; PG8_SCHED;
        }
        if constexpr (ALIGN_EPI) { if (wr == 0) PG8_BAR; }
        if constexpr (!Epi::AFTER_DRAIN) { E.template run<2>(acc, cur.pm * BM, cur.pn, wr, wc, fr, fq); S.done(cur); }
        if (!has_next) break;
#pragma unroll
        for (int a = 0; a < 2; ++a)
#pragma unroll
            for (int b = 0; b < 2; ++b)
#pragma unroll
                for (int m = 0; m < 4; ++m)
#pragma unroll
                    for (int n = 0; n < 2; ++n) acc[a][b][m][n] = (f32x4){0.f, 0.f, 0.f, 0.f};
        cur = nxt; cA = nA; cB = nB; ++ui;
        if constexpr (ALIGN_EPI) { if (wr == 1) PG8_BAR; }
    }
    PG8_WAIT_V(0);
    if constexpr (!ALIGN_EPI) { if (wr == 0) PG8_BAR; }
    PG8_BAR;
    if constexpr (Epi::AFTER_DRAIN) { E.fused(acc, cur, wr, wc, fr, fq, lds, wid, lane); S.done(cur); }
#undef PG8_SA
#undef PG8_SB
#undef PG8_STAGE
#undef PG8_LDA
#undef PG8_LDB
#undef PG8_MMA
#undef PG8_WAIT_V
#undef PG8_WAIT_L
#undef PG8_BAR
#undef PG8_SCHED
}

template <class Epi>
__device__ __forceinline__ void gemm_half_phase(PG8_LAS unsigned char* lds, const bf16_t* Ah, const bf16_t* Bh, int K, int rowbase, int pn, const Epi& E) {
    int tid = threadIdx.x; asm volatile("" : "+v"(tid));
    const int wid = __builtin_amdgcn_readfirstlane(tid >> 6), lane = tid & 63, wr = wid >> 2, wc = wid & 3, fr = lane & 15, fq = lane >> 4;
    const int nt = K / BK;
    unsigned voffA[2], voffB[2];
#pragma unroll
    for (int i = 0; i < 2; ++i) { int R, C; stage_rc(tid * 16 + i * 8192, R, C); const int Rb = Epi::PERM ? ((R & ~31) + perm32(R & 31)) : R;
        voffA[i] = (unsigned)(R * K + C) * 2u; voffB[i] = (unsigned)(Rb * K + C) * 2u; }
    const size_t kstep = (size_t)(BK * 2);
    const size_t hstep = (size_t)HALF * K * 2;
    const unsigned ldsw = (unsigned)wid * 1024u;
    const int aoff = lds_byte(wr * 64 + fr, fq * 8), boff = lds_byte(wc * 32 + fr, fq * 8);
    constexpr int SST = 3 * HTB;
#define PH_STAGE(bufoff, gbase, voff) do { _Pragma("unroll") for (int _i = 0; _i < 2; ++_i) \
        __builtin_amdgcn_global_load_lds((const unsigned*)((const char*)(gbase) + (voff)[_i]), (PG8_LAS unsigned*)(lds + (bufoff) + ldsw + _i * 8192), 16, 0, 0); } while (0)
#define PH_STAGE_TILE(so, tt) do { PH_STAGE((so) + HTB, cB + (size_t)(tt) * kstep, voffB); PH_STAGE((so) + 2 * HTB, cB + hstep + (size_t)(tt) * kstep, voffB); PH_STAGE((so), cA + (size_t)(tt) * kstep, voffA); } while (0)
#define PH_LDA(dst, so) do { _Pragma("unroll") for (int m = 0; m < 4; ++m) _Pragma("unroll") for (int k = 0; k < 2; ++k) dst[m][k] = *(const PG8_LAS bf16x8*)(lds + (so) + aoff + m * 2048 + k * 1024); } while (0)
#define PH_LDB(dst, so, h) do { _Pragma("unroll") for (int n = 0; n < 2; ++n) _Pragma("unroll") for (int k = 0; k < 2; ++k) dst[n][k] = *(const PG8_LAS bf16x8*)(lds + (so) + HTB + (h) * HTB + boff + n * 2048 + k * 1024); } while (0)
#define PH_MMA(bj, At, Bt) do { __builtin_amdgcn_s_setprio(1); _Pragma("unroll") for (int m = 0; m < 4; ++m) _Pragma("unroll") for (int n = 0; n < 2; ++n) _Pragma("unroll") for (int k = 0; k < 2; ++k) \
        acc[0][bj][m][n] = __builtin_amdgcn_mfma_f32_16x16x32_bf16(Bt[n][k], At[m][k], acc[0][bj][m][n], 0, 0, 0); __builtin_amdgcn_s_setprio(0); } while (0)
#define PH_WAIT_V(n) asm volatile("s_waitcnt vmcnt(" #n ")" ::: "memory")
#define PH_WAIT_L(n) asm volatile("s_waitcnt lgkmcnt(" #n ")" ::: "memory")
#define PH_BAR __builtin_amdgcn_s_barrier()
#define PH_SCHED __builtin_amdgcn_sched_barrier(0)
    f32x4 acc[1][2][4][2];
#pragma unroll
    for (int b = 0; b < 2; ++b)
#pragma unroll
        for (int m = 0; m < 4; ++m)
#pragma unroll
            for (int n = 0; n < 2; ++n) acc[0][b][m][n] = (f32x4){0.f, 0.f, 0.f, 0.f};
    bf16x8 At[4][2], B0[2][2], B1[2][2];
    const char* cA = (const char*)Ah; const char* cB = (const char*)Bh;
    PH_STAGE_TILE(0, 0); PH_STAGE_TILE(SST, 1);
    if (wr == 1) PH_BAR;
    PH_WAIT_V(6); PH_BAR;
    PH_BAR;
    int so = 0, so2 = 2 * SST;
    for (int t = 0; t < nt; ++t) {
        const int t2 = (t + 2 < nt) ? t + 2 : t + 2 - nt;
        PH_LDB(B0, so, 0); PH_LDB(B1, so, 1); PH_SCHED; PH_LDA(At, so); PH_STAGE_TILE(so2, t2);
        PH_WAIT_V(6); PH_WAIT_L(0); PH_BAR; PH_MMA(0, At, B0); PH_MMA(1, At, B1); PH_BAR; PH_SCHED;
        so = (so == 2 * SST) ? 0 : so + SST; so2 = (so2 == 2 * SST) ? 0 : so2 + SST;
    }
    E.template run<1>(acc, rowbase, pn, wr, wc, fr, fq);
    PH_WAIT_V(0);
    if (wr == 0) PH_BAR;
    PH_BAR;
#undef PH_STAGE
#undef PH_STAGE_TILE
#undef PH_LDA
#undef PH_LDB
#undef PH_MMA
#undef PH_WAIT_V
#undef PH_WAIT_L
#undef PH_BAR
#undef PH_SCHED
}
}

__device__ __forceinline__ float wave_sum(float v) {
#pragma unroll
    for (int o = 1; o < 64; o <<= 1) v += __shfl_xor(v, o);
    return v;
}
template <bool GLU_PERM>
__device__ __forceinline__ void p0_transpose_item(const float* W, int K, int N, bf16_t* WT, LAS float* scr, int item, int lane) {
    const int nblk = N / 32, kb = item / nblk, nb = item % nblk, k0 = 64 * kb, n0 = 32 * nb;
    int d0 = n0;
    if (GLU_PERM) { if (n0 >= ZC_U1 && n0 < ZC_U2) { const int ch = n0 - ZC_U1; d0 = ZC_U1 + 256 * (ch >> 7) + (ch & 127); } else if (n0 >= ZC_U2 && n0 < ZC_GC) { const int ch = n0 - ZC_U2; d0 = ZC_U1 + 256 * (ch >> 7) + 128 + (ch & 127); } }
    float tv[32];
#pragma unroll
    for (int i = 0; i < 32; ++i) { const int kk = 2 * i + (lane >> 5); tv[i] = __builtin_nontemporal_load(W + (size_t)(k0 + kk) * N + n0 + (lane & 31)); }
#pragma unroll
    for (int i = 0; i < 32; ++i) { const int kk = 2 * i + (lane >> 5); scr[kk * 33 + (lane & 31)] = tv[i]; }
    asm volatile("s_waitcnt lgkmcnt(0)" ::: "memory");
    const int c = lane & 7;
#pragma unroll
    for (int j = 0; j < 4; ++j) { const int n = (lane >> 3) + 8 * j; const LAS float* s = scr + (8 * c) * 33 + n;
        u32x4 o; o.x = cvt_pk_bf16(s[0 * 33], s[1 * 33]); o.y = cvt_pk_bf16(s[2 * 33], s[3 * 33]); o.z = cvt_pk_bf16(s[4 * 33], s[5 * 33]); o.w = cvt_pk_bf16(s[6 * 33], s[7 * 33]);
        *(u32x4*)(WT + (size_t)(d0 + n) * K + k0 + 8 * c) = o; }
    asm volatile("s_waitcnt lgkmcnt(0)" ::: "memory");
}

struct Args {
    const float *x, *meta, *pre_w, *post_w, *w_in, *b_in, *lcw, *lcb, *wga, *bga, *wgx, *bgx, *lam, *cdw, *cdb, *clw, *clb, *cpw, *cpb, *w_out;
    float* out; unsigned char* ws;
};

__device__ __forceinline__ const bf16_t* zrow(const bf16_t* Z, int b, int hidx) { const int row = hidx < NMETA ? MX + hidx : b * SEQ + hidx - NMETA; return Z + (size_t)row * NIN; }

template <int N> struct RS {
    template <int MASK> static __device__ __forceinline__ void step(float (&v)[64], int lane) {
#pragma unroll
        for (int j = 0; j < N; ++j) { const float lo = v[j], hi = v[j + N]; const bool up = (lane & MASK) != 0; const float send = up ? lo : hi, keep = up ? hi : lo; v[j] = keep + __shfl_xor(send, MASK); }
    }
};

template <int RR> __device__ __forceinline__ void conv_row(f32x2 (&ac)[32], const f32x2 (&wk)[31], const LAS unsigned char* p) {
    const unsigned v = *(const LAS unsigned*)(p + RR * 2048); const f32x2 v2 = (f32x2){bf_lo(v), bf_hi(v)};
    constexpr int lo = RR - 30 > 0 ? RR - 30 : 0, hi = RR < 31 ? RR : 31;
#pragma unroll
    for (int o = lo; o <= hi; ++o) ac[o] = __builtin_elementwise_fma(wk[RR - o], v2, ac[o]);
}
template <int... R> __device__ __forceinline__ void conv_all(f32x2 (&ac)[32], const f32x2 (&wk)[31], const LAS unsigned char* p, std::integer_sequence<int, R...>) { (conv_row<R>(ac, wk, p), ...); }

__device__ __forceinline__ void conf_load_weights(const Args& A, f32x2 (&wk)[31]) {
    int tid = threadIdx.x; asm volatile("" : "+v"(tid));
    const char* wp = (const char*)(A.cdw + 2 * tid);
#pragma unroll
    for (int k = 0; k < 31; ++k) { wk[k] = *(const f32x2*)wp; wp += DC * 4; asm volatile("" : "+v"(wp)); }
}
__device__ __forceinline__ void conf_tile(const Args& A, const bf16_t* Z, bf16_t* VLN, LAS unsigned char* lds, int ti, const f32x2 (&wk)[31]) {
    int tid = threadIdx.x; asm volatile("" : "+v"(tid));
    const int lane = tid & 63, wid = tid >> 6;
    const int b = ti >> 6, t0 = (ti & 63) * 32, i0 = NMETA + t0;
    LAS float* red = (LAS float*)(lds + 126976);
    LAS float* stats = (LAS float*)(lds + 129024);
    { u32x4 tv[16];
#pragma unroll
      for (int it = 0; it < 16; ++it) { const int idx = tid + 512 * it; const int rr = idx >> 7, c8 = idx & 127; const int hidx = i0 - 30 + rr;
          tv[it] = (u32x4){0u, 0u, 0u, 0u};
          if (idx < 62 * 128 && hidx >= 0) tv[it] = *(const u32x4*)(zrow(Z, b, hidx) + ZC_U1 + 8 * c8); }
#pragma unroll
      for (int it = 0; it < 16; ++it) { const int idx = tid + 512 * it; const int rr = idx >> 7, c8 = idx & 127;
          if (idx < 62 * 128) *(LAS u32x4*)(lds + rr * 2048 + c8 * 16) = tv[it]; } }
    __syncthreads();
    f32x2 ac[32];
    { const f32x2 bb = *(const f32x2*)(A.cdb + 2 * tid);
#pragma unroll
      for (int o = 0; o < 32; ++o) ac[o] = bb; }
    conv_all(ac, wk, lds + tid * 4, std::make_integer_sequence<int, 62>{});
    float v[64];
#pragma unroll
    for (int o = 0; o < 32; ++o) { v[2 * o] = ac[o].x + ac[o].y; v[2 * o + 1] = ac[o].x * ac[o].x + ac[o].y * ac[o].y; }
    RS<32>::step<32>(v, lane); RS<16>::step<16>(v, lane); RS<8>::step<8>(v, lane); RS<4>::step<4>(v, lane); RS<2>::step<2>(v, lane); RS<1>::step<1>(v, lane);
    red[wid * 64 + lane] = v[0];
    __syncthreads();
    if (tid < 64) { float s = 0.f;
#pragma unroll
        for (int w = 0; w < 8; ++w) s += red[w * 64 + tid];
        red[tid] = s; }
    __syncthreads();
    if (tid < 32) { const float s1 = red[2 * tid], s2 = red[2 * tid + 1]; const float mean = s1 * (1.0f / DC); const float var = s2 * (1.0f / DC) - mean * mean;
        stats[2 * tid] = mean; stats[2 * tid + 1] = 1.0f / sqrtf(fmaxf(var, 0.f) + EPS); }
    __syncthreads();
    const f32x2 lw = *(const f32x2*)(A.clw + 2 * tid), lb = *(const f32x2*)(A.clb + 2 * tid);
    unsigned* op = (unsigned*)(VLN + (size_t)(b * SEQ + t0) * DC + 2 * tid);
#pragma unroll
    for (int o = 0; o < 32; ++o) { const float mean = stats[2 * o], rstd = stats[2 * o + 1];
        const float y0 = (ac[o].x - mean) * rstd * lw.x + lb.x, y1 = (ac[o].y - mean) * rstd * lw.y + lb.y;
        op[(size_t)o * (DC / 2)] = cvt_pk_bf16(siluf(y0), siluf(y1)); }
    __syncthreads();
}

constexpr int L_WL = 0, L_CW = 16384, L_CST = 17664, L_XT = 18688, XT_STRIDE = 144, XT_BYTES = 16 * XT_STRIDE, L_WT = L_XT + 8 * XT_BYTES;
static_assert(L_WT == 37120, "lds map");
constexpr int L_XS = L_WT + 4096, XS_STRIDE = 144, XS_ROWS = 515, L_YT = L_XS, YT_STRIDE = 144, YT_BYTES = 64 * YT_STRIDE;
static_assert(L_XS + XS_ROWS * XS_STRIDE <= 131072 && L_YT + 8 * YT_BYTES <= 131072 && 61 * XS_STRIDE >= 8448, "lds map");

template <bool STASH, bool FROM_LDS>
__device__ __forceinline__ void lru_mtile(const bf16_t* Z, int b, int h, int hb, const LAS unsigned char* xs, LAS unsigned char* lds, LAS unsigned char* xt, int lane,
                                          float (&cP)[4], float (&cH)[4], float (&sH)[4][4], float (&sP)[4][4]) {
    const int r = lane & 15, kq = lane >> 4;
    const LAS float* cw = (const LAS float*)(lds + L_CW);
    const LAS float* cst = (const LAS float*)(lds + L_CST);
    float xc[2][8];
#pragma unroll
    for (int ks = 0; ks < 2; ++ks) { const f32x4 b0 = *(const LAS f32x4*)(cw + 4 * 64 + 32 * ks + 8 * kq), b1 = *(const LAS f32x4*)(cw + 4 * 64 + 32 * ks + 8 * kq + 4);
        xc[ks][0] = b0[0]; xc[ks][1] = b0[1]; xc[ks][2] = b0[2]; xc[ks][3] = b0[3]; xc[ks][4] = b1[0]; xc[ks][5] = b1[1]; xc[ks][6] = b1[2]; xc[ks][7] = b1[3]; }
#pragma unroll
    for (int k = 0; k < 4; ++k) { const int hidx = hb + r - 3 + k;
        if (FROM_LDS || hidx >= 0) { const bf16_t* rp = zrow(Z, b, hidx < 0 ? 0 : hidx) + ZC_XL + 64 * h + 8 * kq;
#pragma unroll
            for (int ks = 0; ks < 2; ++ks) { u32x4 v;
                if (FROM_LDS) v = *(const LAS u32x4*)(xs + (r + k) * XS_STRIDE + (8 * kq + 32 * ks) * 2); else v = *(const u32x4*)(rp + 32 * ks);
                const f32x4 w0 = *(const LAS f32x4*)(cw + k * 64 + 32 * ks + 8 * kq), w1 = *(const LAS f32x4*)(cw + k * 64 + 32 * ks + 8 * kq + 4);
                xc[ks][0] += w0[0] * bf_lo(v.x); xc[ks][1] += w0[1] * bf_hi(v.x); xc[ks][2] += w0[2] * bf_lo(v.y); xc[ks][3] += w0[3] * bf_hi(v.y);
                xc[ks][4] += w1[0] * bf_lo(v.z); xc[ks][5] += w1[1] * bf_hi(v.z); xc[ks][6] += w1[2] * bf_lo(v.w); xc[ks][7] += w1[3] * bf_hi(v.w); } } }
    bf16x8 af[2];
#pragma unroll
    for (int ks = 0; ks < 2; ++ks) { u32x4 p; p.x = cvt_pk_bf16(xc[ks][0], xc[ks][1]); p.y = cvt_pk_bf16(xc[ks][2], xc[ks][3]); p.z = cvt_pk_bf16(xc[ks][4], xc[ks][5]); p.w = cvt_pk_bf16(xc[ks][6], xc[ks][7]);
        af[ks] = __builtin_bit_cast(bf16x8, p); *(LAS u32x4*)(xt + r * XT_STRIDE + (32 * ks + 8 * kq) * 2) = p; }
    asm volatile("s_waitcnt lgkmcnt(0)" ::: "memory");
    __builtin_amdgcn_wave_barrier();
#pragma unroll
    for (int ct = 0; ct < 4; ++ct) {
        const bf16x8 wa0 = *(const LAS bf16x8*)(lds + L_WL + ((0 * 4 + ct) * 2 + 0) * 1024 + lane * 16), wa1 = *(const LAS bf16x8*)(lds + L_WL + ((0 * 4 + ct) * 2 + 1) * 1024 + lane * 16);
        const bf16x8 wx0 = *(const LAS bf16x8*)(lds + L_WL + ((1 * 4 + ct) * 2 + 0) * 1024 + lane * 16), wx1 = *(const LAS bf16x8*)(lds + L_WL + ((1 * 4 + ct) * 2 + 1) * 1024 + lane * 16);
        f32x4 ra = (f32x4){0.f, 0.f, 0.f, 0.f}, ia = (f32x4){0.f, 0.f, 0.f, 0.f};
        ra = __builtin_amdgcn_mfma_f32_16x16x32_bf16(af[0], wa0, ra, 0, 0, 0); ra = __builtin_amdgcn_mfma_f32_16x16x32_bf16(af[1], wa1, ra, 0, 0, 0);
        ia = __builtin_amdgcn_mfma_f32_16x16x32_bf16(af[0], wx0, ia, 0, 0, 0); ia = __builtin_amdgcn_mfma_f32_16x16x32_bf16(af[1], wx1, ia, 0, 0, 0);
        const f32x4 c4 = *(const LAS f32x4*)(cst + (16 * ct + r) * 4);
        float p[4], hh[4];
#pragma unroll
        for (int j = 0; j < 4; ++j) {
            const float xcv = __uint_as_float((unsigned)(*(const LAS unsigned short*)(xt + (4 * kq + j) * XT_STRIDE + (16 * ct + r) * 2)) << 16);
            const float rr = __builtin_amdgcn_rcpf(1.0f + __builtin_amdgcn_exp2f(__builtin_fmaf(ra[j], -1.44269504f, c4[0])));
            const float ii = __builtin_amdgcn_rcpf(1.0f + __builtin_amdgcn_exp2f(__builtin_fmaf(ia[j], -1.44269504f, c4[1])));
            const float a = __builtin_amdgcn_exp2f(c4[2] * rr);
            const float x2 = c4[3] * rr;
            float om_p = -x2 * __builtin_fmaf(x2, 0.5f, 1.0f), om_b = __builtin_fmaf(-a, a, 1.0f); asm volatile("" : "+v"(om_p), "+v"(om_b));
            const float om = x2 > -2e-3f ? om_p : om_b;
            const float mult = __builtin_amdgcn_sqrtf(om); const float u = mult * ii * xcv;
            if (j == 0) { p[0] = a; hh[0] = u; } else { p[j] = p[j - 1] * a; hh[j] = hh[j - 1] * a + u; } }
        float EP = cP[ct], EH = cH[ct];
#pragma unroll
        for (int q = 0; q < 3; ++q) { float tp = __shfl(p[3], r + 16 * q), th = __shfl(hh[3], r + 16 * q); tp = q < kq ? tp : 1.0f; th = q < kq ? th : 0.0f; EH = EH * tp + th; EP = EP * tp; }
        if (STASH) {
#pragma unroll
            for (int j = 0; j < 4; ++j) { sH[ct][j] = EH * p[j] + hh[j]; sP[ct][j] = EP * p[j]; } }
        const float tP = EP * p[3], tH = EH * p[3] + hh[3];
        cP[ct] = __shfl(tP, r + 48); cH[ct] = __shfl(tH, r + 48);
        if (ct & 1) __builtin_amdgcn_sched_barrier(0);
    }
    __builtin_amdgcn_wave_barrier();
}

__device__ __forceinline__ void lru_fill_tables(const Args& A, int uh, LAS unsigned char* lds, int tid) {
    for (int f = tid; f < 1024; f += 512) { const int l = f & 63, ks = (f >> 6) & 1, ct = (f >> 7) & 3, gsel = f >> 9; const int n = l & 15, kq = l >> 4;
        const float* wsrc = (gsel ? A.wgx : A.wga) + (size_t)uh * 4096 + (size_t)(32 * ks + 8 * kq) * 64 + 16 * ct + n;
        u32x4 p; p.x = cvt_pk_bf16(wsrc[0], wsrc[64]); p.y = cvt_pk_bf16(wsrc[128], wsrc[192]); p.z = cvt_pk_bf16(wsrc[256], wsrc[320]); p.w = cvt_pk_bf16(wsrc[384], wsrc[448]);
        *(LAS u32x4*)(lds + L_WL + ((gsel * 4 + ct) * 2 + ks) * 1024 + l * 16) = p; }
    if (tid < 320) { const int k = tid >> 6, c = tid & 63; ((LAS float*)(lds + L_CW))[tid] = k < 4 ? A.lcw[k * DL + 64 * uh + c] : A.lcb[64 * uh + c]; }
    if (tid < 64) { const int c = 64 * uh + tid; const float lm = A.lam[c]; const float sp = (-lm > 20.f) ? -lm : log1pf(__expf(-lm));
        *(LAS f32x4*)(lds + L_CST + tid * 16) = (f32x4){-1.44269504f * A.bga[c], -1.44269504f * A.bgx[c], -8.0f * sp * 1.44269504f, -16.0f * sp}; }
}

__global__ void __launch_bounds__(512, 2) mega(Args A) {
    extern __shared__ __attribute__((aligned(16))) unsigned char lds_raw[];
    LAS unsigned char* lds = (LAS unsigned char*)lds_raw;
    unsigned* const bwords = (unsigned*)(A.ws + WS_CTL) + 1024;
    unsigned* const iflag = (unsigned*)(A.ws + WS_CTL); unsigned* const idone = iflag + 64; unsigned* const pcnt = iflag + 8192;
    if (threadIdx.x < 2) ((volatile LAS unsigned*)(lds + L_MISC))[threadIdx.x] = 0u;
    if (blockIdx.x == 0 && threadIdx.x < 64) {
        const int l = threadIdx.x;
        if (l < 16) { __hip_atomic_store(&bwords[XB_XCNT(l)], 0u, __ATOMIC_RELAXED, __HIP_MEMORY_SCOPE_AGENT); __hip_atomic_store(&bwords[XB_XSUB(l)], 0u, __ATOMIC_RELAXED, __HIP_MEMORY_SCOPE_AGENT);
                      __hip_atomic_store(&bwords[XB_XGEN(l)], 0u, __ATOMIC_RELAXED, __HIP_MEMORY_SCOPE_AGENT); }
        if (l == 16) __hip_atomic_store(&bwords[XB_TOP], 0u, __ATOMIC_RELAXED, __HIP_MEMORY_SCOPE_AGENT);
        if (l == 17) __hip_atomic_store(&bwords[XB_TOPGEN], 0u, __ATOMIC_RELAXED, __HIP_MEMORY_SCOPE_AGENT);
        if (l == 18) __hip_atomic_store(&bwords[XB_TMO], 0u, __ATOMIC_RELAXED, __HIP_MEMORY_SCOPE_AGENT);
        if (l == 19) __hip_atomic_store(idone, 0u, __ATOMIC_RELAXED, __HIP_MEMORY_SCOPE_AGENT);
        if (l >= 32) __hip_atomic_store(pcnt + 64 * (l - 32), 0u, __ATOMIC_RELAXED, __HIP_MEMORY_SCOPE_AGENT);
        asm volatile("s_waitcnt vmcnt(0)" ::: "memory");
        __builtin_amdgcn_fence(__ATOMIC_RELEASE, "agent");
        asm volatile("s_waitcnt vmcnt(0)" ::: "memory");
        if (l == 0) __hip_atomic_store(iflag, INIT_TOKEN, __ATOMIC_RELEASE, __HIP_MEMORY_SCOPE_AGENT);
    }
    __syncthreads();
    const int G = gridDim.x, bx = blockIdx.x;
#define PHASE_IDS() int tid = threadIdx.x; asm volatile("" : "+v"(tid)); const int lane = tid & 63, wid = __builtin_amdgcn_readfirstlane(tid >> 6); (void)lane; (void)wid
    unsigned char* ws = A.ws;
    bf16_t* W1T = (bf16_t*)(ws + WS_W1T); bf16_t* W3T = (bf16_t*)(ws + WS_W3T); bf16_t* WPT = (bf16_t*)(ws + WS_WPT);
    bf16_t* HN = (bf16_t*)(ws + WS_HN); bf16_t* Z = (bf16_t*)(ws + WS_Z); bf16_t* VLN = (bf16_t*)(ws + WS_VLN); bf16_t* Y = (bf16_t*)(ws + WS_Y);
    float* PART = (float*)(ws + WS_PART); f32x2* CARRY = (f32x2*)(ws + WS_CARRY); float* HMETA = (float*)(ws + WS_CARRY + 512 * 1024);

    for (int rep = 0; rep <= PROBE_P0; ++rep) {
        PHASE_IDS();
        LAS float* scr = (LAS float*)(lds + wid * 8448);
        const int gw = bx * 8 + wid, NGW = G * 8;
        constexpr int I1 = (DM / 64) * (NIN / 32);
        for (int it = gw; it < I1; it += NGW) p0_transpose_item<true>(A.w_in, DM, NIN, W1T, scr, it, lane);
        for (int m = gw; m < MX + NMETA; m += NGW) {
            u32x2* o8 = (u32x2*)(HN + (size_t)m * DM) + lane;
            if (m >= MX + NMETA) {
#pragma unroll
                for (int j = 0; j < 8; ++j) o8[64 * j] = (u32x2){0u, 0u};
                continue; }
            const float* src = m < MX ? A.x + (size_t)m * DM : A.meta + (size_t)(m - MX) * DM;
            const f32x4* s4 = (const f32x4*)src + lane; f32x4 v[8]; float ss = 0.f;
#pragma unroll
            for (int j = 0; j < 8; ++j) { v[j] = __builtin_nontemporal_load(s4 + 64 * j); ss += (v[j][0] * v[j][0] + v[j][1] * v[j][1]) + (v[j][2] * v[j][2] + v[j][3] * v[j][3]); }
            const float rstd = 1.0f / sqrtf(wave_sum(ss) * (1.0f / DM) + EPS);
            const f32x4* w4 = (const f32x4*)A.pre_w + lane;
#pragma unroll
            for (int j = 0; j < 8; ++j) { const f32x4 w = w4[64 * j]; o8[64 * j] = (u32x2){cvt_pk_bf16(v[j][0] * rstd * w[0], v[j][1] * rstd * w[1]), cvt_pk_bf16(v[j][2] * rstd * w[2], v[j][3] * rstd * w[3])}; }
        }
    }
    if (threadIdx.x == 0) { unsigned sp = 0; while (__hip_atomic_load(iflag, __ATOMIC_RELAXED, __HIP_MEMORY_SCOPE_AGENT) != INIT_TOKEN) { __builtin_amdgcn_s_sleep(2); if (++sp > (1u << 22)) break; }
        __builtin_amdgcn_fence(__ATOMIC_ACQUIRE, "agent"); }
    __syncthreads();
    const XcdBarrier gbar = xcd_barrier_post(bwords, (volatile LAS unsigned*)(lds + L_MISC));
    xcd_barrier(gbar, 1u);

    for (int rep = 0; rep <= PROBE_P1; ++rep) {
        {
            PHASE_IDS();
            const int r = lane & 15, kq = lane >> 4; const int job = bx; const bool glu = job >= 192;
            int n1, n2 = 0;
            if (!glu) n1 = 16 * job < ZC_U1 ? 16 * job : 16 * job + 2048;
            else { const int ch0 = 16 * (job - 192); n1 = ZC_U1 + 256 * (ch0 >> 7) + (ch0 & 127); n2 = n1 + 128; }
            const bf16_t* ap = HN + (size_t)(MX + r) * DM + 8 * kq + 256 * wid;
            const bf16_t* bp1 = W1T + (size_t)(n1 + r) * DM + 8 * kq + 256 * wid; const bf16_t* bp2 = W1T + (size_t)(n2 + r) * DM + 8 * kq + 256 * wid;
            f32x4 c1 = (f32x4){0.f, 0.f, 0.f, 0.f}, c2 = (f32x4){0.f, 0.f, 0.f, 0.f};
            if (job < 256) {
#pragma unroll
                for (int ks = 0; ks < 8; ++ks) { const bf16x8 av = *(const bf16x8*)(ap + 32 * ks); const bf16x8 b1 = *(const bf16x8*)(bp1 + 32 * ks);
                    c1 = __builtin_amdgcn_mfma_f32_16x16x32_bf16(av, b1, c1, 0, 0, 0);
                    if (glu) { const bf16x8 b2 = *(const bf16x8*)(bp2 + 32 * ks); c2 = __builtin_amdgcn_mfma_f32_16x16x32_bf16(av, b2, c2, 0, 0, 0); } }
                LAS f32x4* red = (LAS f32x4*)lds;
                red[(wid * 2 + 0) * 64 + lane] = c1; red[(wid * 2 + 1) * 64 + lane] = c2;
            }
            __syncthreads();
            if (job < 256 && wid == 0) { const LAS f32x4* red = (const LAS f32x4*)lds; f32x4 t1 = red[lane], t2 = red[64 + lane];
#pragma unroll
                for (int w = 1; w < 8; ++w) { t1 += red[(w * 2 + 0) * 64 + lane]; t2 += red[(w * 2 + 1) * 64 + lane]; }
                if (!glu) { const float bb = A.b_in[n1 + r];
#pragma unroll
                    for (int j = 0; j < 4; ++j) Z[(size_t)(MX + 4 * kq + j) * NIN + n1 + r] = (bf16_t)(cvt_pk_bf16(t1[j] + bb, 0.f) & 0xffffu); }
                else { const int ch = 16 * (job - 192) + r; const float b1 = A.b_in[ZC_U1 + ch], b2 = A.b_in[ZC_U2 + ch];
#pragma unroll
                    for (int j = 0; j < 4; ++j) Z[(size_t)(MX + 4 * kq + j) * NIN + ZC_U1 + ch] = (bf16_t)(cvt_pk_bf16((t1[j] + b1) * sigm(t2[j] + b2), 0.f) & 0xffffu); } }
            __syncthreads();
        }
        { pg8::EpiZ E{Z, NIN, A.b_in, 0}; pg8::StaticOrder S; S.init(MX, ZC_GC, G, bx);
          pg8::Gemm g{HN, W1T, MX, ZC_GC, DM}; pg8::gemm_phase<pg8::EpiZ, pg8::StaticOrder, true>(lds, g, S, E); }
    }
    const bool split2 = (2 * (MX / 256) * ((NIN - ZC_GC) / 256) == G) && bx < G / 2;
    xcd_barrier_arrive(gbar);
    if (!split2 && !(2 * (MX / 256) * ((NIN - ZC_GC) / 256) == G)) xcd_barrier_wait(gbar, 2u);

    if (2 * (MX / 256) * ((NIN - ZC_GC) / 256) == G) {
        if (bx < G / 2) { pg8::EpiZ E{Z, NIN, A.b_in, ZC_GC / 256}; pg8::StaticOrder S; S.init(MX, NIN - ZC_GC, G / 2, bx);
            pg8::Gemm g{HN, W1T + (size_t)ZC_GC * DM, MX, NIN - ZC_GC, DM}; pg8::gemm_phase<pg8::EpiZ, pg8::StaticOrder, true>(lds, g, S, E);
            xcd_barrier_wait(gbar, 2u); }
        else { f32x2 cwk[31]; conf_load_weights(A, cwk); xcd_barrier_wait(gbar, 2u);
               { const int j = bx - G / 2, t = (j & 7) * (G / 16) + (j >> 3);
                 for (int ti = t; ti < MX / 32; ti += G / 2) conf_tile(A, Z, VLN, lds, ti, cwk); }
            if (bx - G / 2 < 16) { PHASE_IDS(); const int mh = bx - G / 2;
                lru_fill_tables(A, mh, lds, tid);
                __syncthreads();
                if (wid == 0) { float cP[4] = {1.f, 1.f, 1.f, 1.f}, cH[4] = {0.f, 0.f, 0.f, 0.f}; float dH[4][4], dP[4][4];
                    lru_mtile<false, false>(Z, 0, mh, 0, lds, lds, lds + L_XT, lane, cP, cH, dH, dP);
                    if (lane < 16) {
#pragma unroll
                        for (int ct = 0; ct < 4; ++ct) HMETA[mh * 64 + 16 * ct + lane] = cH[ct]; } }
                __syncthreads(); }
            else { PHASE_IDS();
                LAS float* scr = (LAS float*)(lds + wid * 8448);
                const int gw = (bx - G / 2 - 16) * 8 + wid, NGW = (G / 2 - 16) * 8;
                constexpr int I3 = (DM / 64) * (DM / 32), IP = (DC / 64) * (DC / 32);
                for (int it = gw; it < I3 + IP; it += NGW) { if (it < I3) p0_transpose_item<false>(A.w_out, DM, DM, W3T, scr, it, lane); else p0_transpose_item<false>(A.cpw, DC, DC, WPT, scr, it - I3, lane); } } }
    } else {
        { pg8::EpiZ E{Z, NIN, A.b_in, ZC_GC / 256}; pg8::StaticOrder S; S.init(MX, NIN - ZC_GC, G, bx);
          pg8::Gemm g{HN, W1T + (size_t)ZC_GC * DM, MX, NIN - ZC_GC, DM}; pg8::gemm_phase<pg8::EpiZ, pg8::StaticOrder, true>(lds, g, S, E); }
        { f32x2 cwk[31]; conf_load_weights(A, cwk); for (int ti = bx; ti < MX / 32; ti += G) conf_tile(A, Z, VLN, lds, ti, cwk); }
    }
    __syncthreads();

    const int ub = bx >> 6, uh = (bx >> 2) & 15, uq = bx & 3;
    float sH[4][4][4], sP[4][4][4];
    for (int rep = 0; rep <= PROBE_P2B; ++rep) {
        if (rep) __syncthreads();
        PHASE_IDS();
        { u32x4 tv[9];
#pragma unroll
          for (int it = 0; it < 9; ++it) { const int idx = tid + 512 * it; const int row = idx >> 3, c = idx & 7; tv[it] = (u32x4){0u, 0u, 0u, 0u};
              if (idx < XS_ROWS * 8) tv[it] = *(const u32x4*)(zrow(Z, ub, NMETA + 512 * uq - 3 + row) + ZC_XL + 64 * uh + 8 * c); }
#pragma unroll
          for (int it = 0; it < 9; ++it) { const int idx = tid + 512 * it; const int row = idx >> 3, c = idx & 7;
              if (idx < XS_ROWS * 8) *(LAS u32x4*)(lds + L_XS + row * XS_STRIDE + c * 16) = tv[it]; } }
        lru_fill_tables(A, uh, lds, tid);
        __syncthreads();
        LAS unsigned char* xt = lds + L_XT + wid * XT_BYTES;
        float cP[4] = {1.f, 1.f, 1.f, 1.f}, cH[4] = {0.f, 0.f, 0.f, 0.f};
        const int hb0 = NMETA + 512 * uq + 64 * wid;
#pragma unroll
        for (int mt = 0; mt < 4; ++mt) lru_mtile<true, true>(Z, ub, uh, hb0 + 16 * mt, lds + L_XS + (64 * wid + 16 * mt) * XS_STRIDE, lds, xt, lane, cP, cH, sH[mt], sP[mt]);
        LAS f32x2* wt = (LAS f32x2*)(lds + L_WT);
        if (lane < 16) {
#pragma unroll
            for (int ct = 0; ct < 4; ++ct) wt[wid * 64 + 16 * ct + lane] = (f32x2){cP[ct], cH[ct]}; }
        __syncthreads();
        if (tid < 64) { float P = 1.f, H = 0.f;
#pragma unroll
            for (int w = 0; w < 8; ++w) { const f32x2 t = wt[w * 64 + tid]; H = H * t.x + t.y; P = P * t.x; }
            CARRY[((ub * 16 + uh) * 4 + uq) * 64 + tid] = (f32x2){P, H}; }
    }
    xcd_barrier_arrive(gbar);
    u32x4 gq[8];
    { const int lane_ = threadIdx.x & 63, wid_ = threadIdx.x >> 6;
#pragma unroll
      for (int i = 0; i < 8; ++i) { const int piece = lane_ + 64 * i, tl = piece >> 3, c8 = piece & 7; const size_t row = (size_t)ub * SEQ + 512 * uq + 64 * wid_ + tl;
          gq[i] = *(const u32x4*)(Z + row * NIN + ZC_GL + 64 * uh + 8 * c8); } }
    xcd_barrier_wait(gbar, 3u);

    {
        PHASE_IDS();
        const LAS f32x2* wt = (const LAS f32x2*)(lds + L_WT);
        LAS unsigned char* yt = lds + L_YT + wid * YT_BYTES;
        const int r = lane & 15, kq = lane >> 4;
#pragma unroll
        for (int ct = 0; ct < 4; ++ct) { const int c = 16 * ct + r; float hin = HMETA[uh * 64 + c];
            for (int q = 0; q < uq; ++q) { const f32x2 t = CARRY[((ub * 16 + uh) * 4 + q) * 64 + c]; hin = hin * t.x + t.y; }
            for (int w = 0; w < wid; ++w) { const f32x2 t = wt[w * 64 + c]; hin = hin * t.x + t.y; }
#pragma unroll
            for (int mt = 0; mt < 4; ++mt)
#pragma unroll
                for (int j = 0; j < 4; ++j) { const float hv = sH[mt][ct][j] + sP[mt][ct][j] * hin;
                    *(LAS unsigned short*)(yt + (16 * mt + 4 * kq + j) * YT_STRIDE + c * 2) = (unsigned short)(cvt_pk_bf16(hv, 0.f) & 0xffffu); } }
        asm volatile("s_waitcnt lgkmcnt(0)" ::: "memory");
        __builtin_amdgcn_wave_barrier();
#pragma unroll
        for (int i = 0; i < 8; ++i) { const int piece = lane + 64 * i, tl = piece >> 3, c8 = piece & 7;
            const u32x4 hv = *(const LAS u32x4*)(yt + tl * YT_STRIDE + c8 * 16);
            const size_t row = (size_t)ub * SEQ + 512 * uq + 64 * wid + tl;
            const u32x4 g = gq[i];
            u32x4 o;
            o.x = cvt_pk_bf16(bf_lo(hv.x) * siluf(bf_lo(g.x)), bf_hi(hv.x) * siluf(bf_hi(g.x)));
            o.y = cvt_pk_bf16(bf_lo(hv.y) * siluf(bf_lo(g.y)), bf_hi(hv.y) * siluf(bf_hi(g.y)));
            o.z = cvt_pk_bf16(bf_lo(hv.z) * siluf(bf_lo(g.z)), bf_hi(hv.z) * siluf(bf_hi(g.z)));
            o.w = cvt_pk_bf16(bf_lo(hv.w) * siluf(bf_lo(g.w)), bf_hi(hv.w) * siluf(bf_hi(g.w)));
            *(u32x4*)(Y + row * DM + 64 * uh + 8 * c8) = o; }
    }
    __syncthreads();

    for (int rep = 0; rep <= PROBE_P3; ++rep) {
        pg8::EpiPW E{Y, Z, A.cpb};
        pg8::StaticOrder S; S.init(MX, DC, G, bx);
        if (2 * S.nwg == G) { pg8::Unit u; S.at((bx & 7) + 8 * (bx >> 4), u); const int rowbase = u.pm * 256 + 128 * ((bx >> 3) & 1);
            pg8::gemm_half_phase<pg8::EpiPW>(lds, VLN + (size_t)rowbase * DC, WPT + (size_t)u.pn * 256 * DC, DC, rowbase, u.pn, E); }
        else { pg8::Gemm g{VLN, WPT, MX, DC, DC}; pg8::gemm_phase<pg8::EpiPW, pg8::StaticOrder, true>(lds, g, S, E); }
    }
    xcd_barrier(gbar, 4u);

    {
        pg8::Gemm g{Y, W3T, MX, DM, DM}; pg8::StaticOrder S; S.init(MX, DM, G, bx);
        pg8::EpiOut E{A.x, A.out, A.post_w, PART, pcnt};
        pg8::gemm_phase<pg8::EpiOut, pg8::StaticOrder, false>(lds, g, S, E);
    }
    __syncthreads();
    if (threadIdx.x == 0) { const unsigned old = __hip_atomic_fetch_add(idone, 1u, __ATOMIC_RELAXED, __HIP_MEMORY_SCOPE_AGENT); if (old + 1u == (unsigned)G) __hip_atomic_store(iflag, 0u, __ATOMIC_RELAXED, __HIP_MEMORY_SCOPE_AGENT); }
}

extern "C" void kernel_launch(void* const* d_in, const int* in_sizes, int n_in, void* d_out, int out_size, void* d_ws, size_t ws_size, hipStream_t stream) {
    static int grid = 0;
    if (grid == 0) {
        if (n_in != 20 || out_size != MX * DM || ws_size < WS_END) { fprintf(stderr, "kernel_launch: unexpected problem shape (n_in %d out %d ws %zu)\n", n_in, out_size, ws_size); grid = -1; return; }
        int dev = 0, cus = 0, per_cu = 0;
        hipGetDevice(&dev); hipDeviceGetAttribute(&cus, hipDeviceAttributeMultiprocessorCount, dev);
        if (hipFuncSetAttribute((const void*)mega, hipFuncAttributeMaxDynamicSharedMemorySize, LDS_BYTES) != hipSuccess) { fprintf(stderr, "kernel_launch: hipFuncSetAttribute failed\n"); grid = -1; return; }
        hipOccupancyMaxActiveBlocksPerMultiprocessor(&per_cu, (const void*)mega, 512, LDS_BYTES);
        if (cus * per_cu < 256) { fprintf(stderr, "kernel_launch: need 256 resident workgroups, device offers %d x %d\n", cus, per_cu); grid = -1; return; }
        grid = 256;
    }
    if (grid < 0) return;
    Args a{};
    const float** ap = (const float**)&a;
    for (int i = 0; i < 20; ++i) ap[i] = (const float*)d_in[i];
    a.out = (float*)d_out; a.ws = (unsigned char*)d_ws;
    void* args[] = {&a};
    hipError_t e = hipLaunchCooperativeKernel((const void*)mega, dim3(grid), dim3(512), args, LDS_BYTES, stream);
    if (e != hipSuccess) fprintf(stderr, "cooperative launch failed: %s\n", hipGetErrorString(e));
}
```
